# Optimizing an MI355X kernel written in HIP

```python
import math
import jax
import jax.numpy as jnp
from jax import lax
import numpy as np


D_MODEL = 1024
BATCH = 2
SEQ = 8192
DEPTH = 2

GRID_W = 64
CTX_LEN = 256
EPS = 1e-6
NEG_INF = -1e30
N_MOD = 6
D_FF = 4 * D_MODEL
ROPE_BASE = 10000.0

HY_WIDTH = D_MODEL // 2
HY_SHORT = 3
HY_EMB = 33
HY_BANDS = (HY_EMB - 1) // 2
HY_HIDDEN = 64
HY_TARGET = 1e-2
HY_FAST_PCT = 0.3
HY_SLOW_PCT = 1.5
HY_MIN_DECAY = -math.log(HY_TARGET) / HY_SLOW_PCT
HY_MAX_DECAY = -math.log(HY_TARGET) / HY_FAST_PCT

ATT_HEADS = 8
ATT_KV_HEADS = 2
ATT_GROUP = ATT_HEADS // ATT_KV_HEADS
HEAD_DIM = 64
ATT_WIDTH = ATT_HEADS * HEAD_DIM
KV_WIDTH = ATT_KV_HEADS * HEAD_DIM
WINDOW = 128
BLOCK = 128

EV_IN = 3 * HY_WIDTH + ATT_WIDTH + 2 * KV_WIDTH
EV_OUT = HY_WIDTH + ATT_WIDTH

RET_HEADS = 4
RET_DK = D_MODEL // RET_HEADS
RET_DV = 2 * RET_DK
RET_CHUNK = 128
RET_QK = RET_HEADS * RET_DK
RET_V = RET_HEADS * RET_DV
OD_IN = 2 * RET_QK + 3 * RET_V
OD_OUT = RET_V

N_EVEN = (DEPTH + 1) // 2
N_ODD = DEPTH // 2

kernel_name = 'hybrid_hyena_swa_retention_dit'


def rms_norm(x, g):
    xf = x.astype(jnp.float32)
    y = xf * lax.rsqrt(jnp.mean(xf * xf, axis=-1, keepdims=True) + EPS)
    return (y * g.astype(jnp.float32)).astype(x.dtype)


def modulate(h, shift, scale):
    return h * (1 + scale) + shift


def sq_relu_mlp(h, w1, w2):
    return jnp.square(jax.nn.relu(h @ w1)) @ w2


def rotate_half(x, cos, sin):
    x1, x2 = jnp.split(x, 2, axis=-1)
    return jnp.concatenate([x1 * cos - x2 * sin, x2 * cos + x1 * sin], axis=-1)


def rope_2d(x, pos_row, pos_col):
    half, quarter = HEAD_DIM // 2, HEAD_DIM // 4
    inv = ROPE_BASE ** (-jnp.arange(quarter, dtype=jnp.float32) / quarter)
    parts = []
    for xa, pos in ((x[..., :half], pos_row), (x[..., half:], pos_col)):
        ang = pos[:, None] * inv[None, :]
        parts.append(rotate_half(xa, jnp.cos(ang)[:, None, :].astype(x.dtype), jnp.sin(ang)[:, None, :].astype(x.dtype)))
    return jnp.concatenate(parts, axis=-1)


def rope_1d(x, pos):
    inv = ROPE_BASE ** (-jnp.linspace(0.0, 1.0, RET_DK // 2, dtype=jnp.float32))
    ang = pos[:, None] * inv[None, :]
    return rotate_half(x, jnp.cos(ang), jnp.sin(ang))


def short_conv(u, w, b):
    L = u.shape[1]
    up = jnp.pad(u, ((0, 0), (1, 1), (0, 0)))
    return up[:, :L] * w[0] + up[:, 1:L + 1] * w[1] + up[:, 2:] * w[2] + b


def hyena_filter_freq(L, w1, b1, w2, b2, w3, freq, decay):
    f32 = jnp.float32
    t = (jnp.arange(L, dtype=f32) / L)[:, None]
    bands = jnp.linspace(1e-4, HY_BANDS - 1, HY_BANDS, dtype=f32)
    ang = 2.0 * math.pi * t * bands[None, :]
    z = jnp.concatenate([t, jnp.cos(ang), -jnp.sin(ang)], axis=-1)
    fr = freq.astype(f32)
    hid = jnp.sin(fr * (z @ w1.astype(f32) + b1.astype(f32)))
    hid = jnp.sin(fr * (hid @ w2.astype(f32) + b2.astype(f32)))
    h = (hid @ w3.astype(f32)).reshape(L, 2, HY_WIDTH)
    h = h * jnp.exp(-t[:, :, None] * jnp.abs(decay.astype(f32))[None])
    h_pos, h_neg = h[:, 0], h[1:, 1]
    norm = jnp.sqrt(jnp.sum(h_pos * h_pos, axis=0) + jnp.sum(h_neg * h_neg, axis=0))
    h_circ = jnp.concatenate([h_pos, jnp.zeros((1, HY_WIDTH), f32), h_neg[::-1]], axis=0) / norm
    return jnp.fft.rfft(h_circ, axis=0)


def hyena(u, conv_w, conv_b, bias, filt):
    L = u.shape[1]
    x0, x1, v = jnp.split(short_conv(u, conv_w, conv_b), 3, axis=-1)
    z = v * x1
    hf = hyena_filter_freq(L, *filt)
    zf = jnp.fft.rfft(z.astype(jnp.float32), n=2 * L, axis=1)
    y = jnp.fft.irfft(zf * hf[None], n=2 * L, axis=1)[:, :L].astype(z.dtype)
    return x0 * (y + z * bias)


def softmax_with_sink(s, sink):
    col = jnp.broadcast_to(sink, s.shape[:-1] + (1,))
    return jax.nn.softmax(jnp.concatenate([s, col], axis=-1), axis=-1)[..., :-1]


def latent_window_attention(q, k, v, k_c, v_c, sink):
    B, S = q.shape[:2]
    nb = S // BLOCK
    n_win = 3 * BLOCK
    scale = HEAD_DIM ** -0.5
    qb = q.reshape(B, nb, BLOCK, ATT_KV_HEADS, ATT_GROUP, HEAD_DIM)

    def band(t):
        tp = jnp.pad(t, ((0, 0), (BLOCK, BLOCK), (0, 0), (0, 0))).reshape(B, nb + 2, BLOCK, ATT_KV_HEADS, HEAD_DIM)
        return jnp.concatenate([tp[:, :-2], tp[:, 1:-1], tp[:, 2:]], axis=2)

    kw, vw = band(k), band(v)
    q_off = jnp.arange(BLOCK)[:, None]
    k_off = jnp.arange(n_win)[None, :] - BLOCK
    key_pos = jnp.arange(nb)[:, None, None] * BLOCK + k_off[None]
    valid = (jnp.abs(q_off - k_off) <= WINDOW)[None] & (key_pos >= 0) & (key_pos < S)
    s_loc = jnp.einsum('bnqkgd,bnskd->bkgnqs', qb, kw).astype(jnp.float32) * scale
    s_loc = jnp.where(valid, s_loc, NEG_INF)
    s_ctx = jnp.einsum('bnqkgd,bckd->bkgnqc', qb, k_c).astype(jnp.float32) * scale
    sink_b = sink.astype(jnp.float32).reshape(1, ATT_KV_HEADS, ATT_GROUP, 1, 1, 1)
    p = softmax_with_sink(jnp.concatenate([s_loc, s_ctx], axis=-1), sink_b).astype(v.dtype)
    o = (jnp.einsum('bkgnqs,bnskd->bnqkgd', p[..., :n_win], vw)
         + jnp.einsum('bkgnqc,bckd->bnqkgd', p[..., n_win:], v_c))
    return o.reshape(B, S, ATT_WIDTH)


def context_attention(q_c, k_c, v_c, sink):
    B, Lc = q_c.shape[:2]
    qg = q_c.reshape(B, Lc, ATT_KV_HEADS, ATT_GROUP, HEAD_DIM)
    s = jnp.einsum('bqkgd,bskd->bkgqs', qg, k_c).astype(jnp.float32) * HEAD_DIM ** -0.5
    p = softmax_with_sink(s, sink.astype(jnp.float32).reshape(1, ATT_KV_HEADS, ATT_GROUP, 1, 1)).astype(v_c.dtype)
    return jnp.einsum('bkgqs,bskd->bqkgd', p, v_c).reshape(B, Lc, ATT_WIDTH)


def even_mixer(h_c, h_l, w_in, w_out, conv_w, conv_b, hy_w1, hy_b1, hy_w2, hy_b2, hy_w3, hy_freq,
               hy_decay, hy_bias, sink, pos_row, pos_col, need_ctx_out):
    filt = (hy_w1, hy_b1, hy_w2, hy_b2, hy_w3, hy_freq, hy_decay)
    i_q = 3 * HY_WIDTH
    i_k = i_q + ATT_WIDTH
    i_v = i_k + KV_WIDTH

    def heads(p):
        B, L, _ = p.shape
        return (p[..., i_q:i_k].reshape(B, L, ATT_HEADS, HEAD_DIM),
                p[..., i_k:i_v].reshape(B, L, ATT_KV_HEADS, HEAD_DIM),
                p[..., i_v:].reshape(B, L, ATT_KV_HEADS, HEAD_DIM))

    p_l = h_l @ w_in
    p_c = h_c @ w_in
    q_l, k_l, v_l = heads(p_l)
    q_c, k_c, v_c = heads(p_c)
    q_l = rope_2d(q_l, pos_row, pos_col)
    k_l = rope_2d(k_l, pos_row, pos_col)
    y_l = jnp.concatenate([hyena(p_l[..., :i_q], conv_w, conv_b, hy_bias, filt),
                           latent_window_attention(q_l, k_l, v_l, k_c, v_c, sink)], axis=-1) @ w_out
    y_c = None
    if need_ctx_out:
        y_c = jnp.concatenate([hyena(p_c[..., :i_q], conv_w, conv_b, hy_bias, filt),
                               context_attention(q_c, k_c, v_c, sink)], axis=-1) @ w_out
    return y_c, y_l


def chunk_retention(q, k, v, state, log_gamma):
    B, H, L, _ = q.shape
    n = L // RET_CHUNK
    idx = jnp.arange(RET_CHUNK, dtype=jnp.float32)
    diff = idx[:, None] - idx[None, :]
    dmask = jnp.exp(jnp.where(diff >= 0, diff[None] * log_gamma[:, None, None], -jnp.inf))
    xi = jnp.exp((idx + 1)[None, :] * log_gamma[:, None])[..., None]
    zeta = jnp.exp((RET_CHUNK - 1 - idx)[None, :] * log_gamma[:, None])[..., None]
    g_chunk = jnp.exp(RET_CHUNK * log_gamma)[:, None, None]

    def to_chunks(t):
        return t.reshape(B, H, n, RET_CHUNK, t.shape[-1]).transpose(2, 0, 1, 3, 4)

    def step(R, inp):
        qn, kn, vn = inp
        inner = jnp.einsum('bhid,bhjd->bhij', qn, kn) * dmask
        o = jnp.einsum('bhij,bhje->bhie', inner, vn) + jnp.einsum('bhid,bhde->bhie', qn * xi, R)
        R = g_chunk * R + jnp.einsum('bhjd,bhje->bhde', kn * zeta, vn)
        return R, o

    state, o = lax.scan(step, state, (to_chunks(q), to_chunks(k), to_chunks(v)))
    return o.transpose(1, 2, 0, 3, 4).reshape(B, H, L, RET_DV), state


def retention_direction(q_c, k_c, v_c, q_l, k_l, v_l, log_gamma):
    B, H, Lc = q_c.shape[:3]
    Ll = q_l.shape[2]
    pos_c = jnp.arange(Lc, dtype=jnp.float32)
    pos_l = Lc + jnp.arange(Ll, dtype=jnp.float32)
    state0 = jnp.zeros((B, H, RET_DK, RET_DV), jnp.float32)
    o_c, state_c = chunk_retention(rope_1d(q_c, pos_c), rope_1d(k_c, pos_c), v_c, state0, log_gamma)
    o_l, _ = chunk_retention(rope_1d(q_l, pos_l), rope_1d(k_l, pos_l), v_l, state_c, log_gamma)
    return o_c, o_l


def head_rms(o):
    o = o * lax.rsqrt(jnp.mean(o * o, axis=-1, keepdims=True) + EPS)
    B, H, L, dv = o.shape
    return o.transpose(0, 2, 1, 3).reshape(B, L, H * dv)


def retention_mixer(h_c, h_l, w_in, w_out, log_rate, need_ctx_out):
    def split(p):
        B, L, _ = p.shape
        f32 = jnp.float32
        q = p[..., :RET_QK].reshape(B, L, RET_HEADS, RET_DK).transpose(0, 2, 1, 3).astype(f32)
        k = p[..., RET_QK:2 * RET_QK].reshape(B, L, RET_HEADS, RET_DK).transpose(0, 2, 1, 3).astype(f32) * RET_DK ** -0.5
        v = p[..., 2 * RET_QK:2 * RET_QK + RET_V].reshape(B, L, RET_HEADS, RET_DV).transpose(0, 2, 1, 3).astype(f32)
        g_f = p[..., 2 * RET_QK + RET_V:2 * RET_QK + 2 * RET_V]
        g_b = p[..., 2 * RET_QK + 2 * RET_V:]
        return q, k, v, g_f, g_b

    q_l, k_l, v_l, gf_l, gb_l = split(h_l @ w_in)
    q_c, k_c, v_c, gf_c, gb_c = split(h_c @ w_in)
    log_gamma = -jnp.exp(log_rate.astype(jnp.float32))

    def flip(t):
        return t[:, :, ::-1]

    of_c, of_l = retention_direction(q_c, k_c, v_c, q_l, k_l, v_l, log_gamma[0])
    ob_c, ob_l = retention_direction(flip(q_c), flip(k_c), flip(v_c), flip(q_l), flip(k_l), flip(v_l), log_gamma[1])

    def merge(o_f, o_b, g_f, g_b):
        y = jax.nn.silu(g_f) * head_rms(o_f).astype(g_f.dtype) + jax.nn.silu(g_b) * head_rms(o_b).astype(g_b.dtype)
        return y @ w_out

    y_l = merge(of_l, flip(ob_l), gf_l, gb_l)
    y_c = None
    if need_ctx_out:
        y_c = merge(of_c, flip(ob_c), gf_c, gb_c)
    return y_c, y_l


def setup_inputs(seed: int = 0) -> dict:
    key = jax.random.key(seed)
    ks = jax.random.split(key, 32)
    D = D_MODEL

    def nrm(k, shape, scale):
        return jax.random.normal(k, shape, jnp.float32) * scale

    hy_base = jnp.linspace(HY_MIN_DECAY, HY_MAX_DECAY, HY_WIDTH, dtype=jnp.float32)
    ret_base = -(5.0 + jnp.arange(RET_HEADS, dtype=jnp.float32)) * math.log(2.0)
    return {
        'x': nrm(ks[0], (BATCH, SEQ, D), 1.0),
        'c': nrm(ks[1], (BATCH, D), 1.0),
        'ctx': nrm(ks[2], (BATCH, CTX_LEN, D), 1.0),
        'c_ctx': nrm(ks[3], (D,), 1.0),
        'ada_w': nrm(ks[4], (DEPTH, D, N_MOD * D), 0.5 * D ** -0.5),
        'ada_b': nrm(ks[5], (DEPTH, N_MOD * D), 0.01),
        'norm_mix_g': 1.0 + nrm(ks[6], (DEPTH, D), 0.02),
        'norm_mlp_g': 1.0 + nrm(ks[7], (DEPTH, D), 0.02),
        'mlp_w1': nrm(ks[8], (DEPTH, D, D_FF), D ** -0.5),
        'mlp_w2': nrm(ks[9], (DEPTH, D_FF, D), D_FF ** -0.5),
        'ev_w_in': nrm(ks[10], (N_EVEN, D, EV_IN), D ** -0.5),
        'ev_w_out': nrm(ks[11], (N_EVEN, EV_OUT, D), EV_OUT ** -0.5),
        'hy_conv_w': nrm(ks[12], (N_EVEN, HY_SHORT, 3 * HY_WIDTH), HY_SHORT ** -0.5),
        'hy_conv_b': nrm(ks[13], (N_EVEN, 3 * HY_WIDTH), 0.02),
        'hy_w1': nrm(ks[14], (N_EVEN, HY_EMB, HY_HIDDEN), HY_EMB ** -0.5),
        'hy_b1': nrm(ks[15], (N_EVEN, HY_HIDDEN), 0.1),
        'hy_w2': nrm(ks[16], (N_EVEN, HY_HIDDEN, HY_HIDDEN), HY_HIDDEN ** -0.5),
        'hy_b2': nrm(ks[17], (N_EVEN, HY_HIDDEN), 0.1),
        'hy_w3': nrm(ks[18], (N_EVEN, HY_HIDDEN, 2 * HY_WIDTH), HY_HIDDEN ** -0.5),
        'hy_freq': 1.0 + nrm(ks[19], (N_EVEN, HY_HIDDEN), 0.1),
        'hy_decay': hy_base * (1.0 + nrm(ks[20], (N_EVEN, 2, HY_WIDTH), 0.05)),
        'hy_bias': nrm(ks[21], (N_EVEN, HY_WIDTH), 1.0),
        'attn_sink': nrm(ks[22], (N_EVEN, ATT_HEADS), 0.5),
        'od_w_in': nrm(ks[23], (N_ODD, D, OD_IN), D ** -0.5),
        'od_w_out': nrm(ks[24], (N_ODD, OD_OUT, D), OD_OUT ** -0.5),
        'ret_log_rate': ret_base + nrm(ks[25], (N_ODD, 2, RET_HEADS), 0.05),
        'final_g': 1.0 + nrm(ks[26], (D,), 0.02),
    }


def reference(x, c, ctx, c_ctx, ada_w, ada_b, norm_mix_g, norm_mlp_g, mlp_w1, mlp_w2,
              ev_w_in, ev_w_out, hy_conv_w, hy_conv_b, hy_w1, hy_b1, hy_w2, hy_b2, hy_w3, hy_freq,
              hy_decay, hy_bias, attn_sink, od_w_in, od_w_out, ret_log_rate, final_g):
    n_tok = x.shape[1]
    rows = n_tok // GRID_W
    grid_r, grid_c = jnp.meshgrid(jnp.arange(rows, dtype=jnp.float32),
                                  jnp.arange(GRID_W, dtype=jnp.float32), indexing='ij')
    pos_row = grid_r.reshape(-1)
    pos_col = grid_c.reshape(-1)
    c_act = jax.nn.silu(c)
    cc_act = jax.nn.silu(c_ctx)

    for i in range(DEPTH):
        need_ctx_out = i < DEPTH - 1
        mod_l = (c_act @ ada_w[i] + ada_b[i])[:, None, :]
        mod_c = cc_act @ ada_w[i] + ada_b[i]
        sh_a, sc_a, g_a, sh_m, sc_m, g_m = jnp.split(mod_l, N_MOD, axis=-1)
        csh_a, csc_a, cg_a, csh_m, csc_m, cg_m = jnp.split(mod_c, N_MOD, axis=-1)
        h_l = modulate(rms_norm(x, norm_mix_g[i]), sh_a, sc_a)
        h_c = modulate(rms_norm(ctx, norm_mix_g[i]), csh_a, csc_a)
        j = i // 2
        if i % 2 == 0:
            y_c, y_l = even_mixer(h_c, h_l, ev_w_in[j], ev_w_out[j], hy_conv_w[j], hy_conv_b[j],
                                  hy_w1[j], hy_b1[j], hy_w2[j], hy_b2[j], hy_w3[j], hy_freq[j],
                                  hy_decay[j], hy_bias[j], attn_sink[j], pos_row, pos_col, need_ctx_out)
        else:
            y_c, y_l = retention_mixer(h_c, h_l, od_w_in[j], od_w_out[j], ret_log_rate[j], need_ctx_out)
        x = x + g_a * y_l
        x = x + g_m * sq_relu_mlp(modulate(rms_norm(x, norm_mlp_g[i]), sh_m, sc_m), mlp_w1[i], mlp_w2[i])
        if need_ctx_out:
            ctx = ctx + cg_a * y_c
            ctx = ctx + cg_m * sq_relu_mlp(modulate(rms_norm(ctx, norm_mlp_g[i]), csh_m, csc_m), mlp_w1[i], mlp_w2[i])

    return rms_norm(x, final_g)
```

```cpp
#include <hip/hip_runtime.h>
#include <hip/hip_cooperative_groups.h>
#include <cstdio>
#include <cstdint>
namespace cg = cooperative_groups;

typedef unsigned short bf16_t;
typedef short bf16x8 __attribute__((ext_vector_type(8)));
typedef short bf16x4 __attribute__((ext_vector_type(4)));
typedef float f32x4 __attribute__((ext_vector_type(4)));

#define NT 512
constexpr int D = 1024, SEQ = 8192, CTXL = 256, RB = 8448, MROWS = 16896;
constexpr int LDS_BYTES = 139264;
constexpr size_t MiB = 1048576;
constexpr size_t OFF_MOD = 0;
constexpr size_t OFF_BAR = 512 * 1024;
constexpr size_t OFF_TW = 1 * MiB;
constexpr size_t OFF_XC = 2 * MiB;
constexpr size_t OFF_WT = 4 * MiB;
constexpr size_t OFF_HA = 40 * MiB;
constexpr size_t OFF_HT = 73 * MiB;
constexpr size_t OFF_HTC = 105 * MiB;
constexpr size_t OFF_PN = 106 * MiB;
constexpr size_t OFF_HF = 108 * MiB;
constexpr size_t OFF_U = 172 * MiB;
constexpr size_t OFF_QR = 222 * MiB;
constexpr size_t OFF_KR = 239 * MiB;
constexpr size_t OFF_VT = 244 * MiB;
constexpr size_t OFF_GT = 73 * MiB;
constexpr size_t OFF_AO = 172 * MiB;
constexpr size_t OFF_HID = 73 * MiB;
constexpr size_t DO_ZT = 0, DO_X0T = 33 * MiB;
constexpr size_t OFF_Q1 = 57 * MiB;
constexpr size_t OFF_KZ = 89 * MiB;
constexpr size_t OFF_V1 = 122 * MiB;
constexpr size_t OFF_IN = 155 * MiB;
constexpr size_t OFF_SG = 171 * MiB;
constexpr size_t OFF_PS = 235 * MiB;
constexpr size_t W0_IN = 0, W0_OUT = W0_IN + 2304 * 1024, W0_1 = W0_OUT + 1024 * 1024, W0_2 = W0_1 + 4096 * 1024;
constexpr size_t W1_IN = 0, W1_OUT = W1_IN + 8192 * 1024, W1_1 = W1_OUT + 1024 * 2048, W1_2 = W1_1 + 4096 * 1024;

struct Params {
    const float *x, *c, *ctx, *c_ctx, *ada_w, *ada_b, *norm_mix_g, *norm_mlp_g, *mlp_w1, *mlp_w2, *ev_w_in, *ev_w_out, *hy_conv_w, *hy_conv_b,
        *hy_w1, *hy_b1, *hy_w2, *hy_b2, *hy_w3, *hy_freq, *hy_decay, *hy_bias, *attn_sink, *od_w_in, *od_w_out, *ret_log_rate, *final_g;
    float* out; unsigned char* ws;
};

__device__ __forceinline__ bf16_t f2bf(float f) { unsigned u = __float_as_uint(f); u += 0x7fffu + ((u >> 16) & 1u); return (bf16_t)(u >> 16); }
__device__ __forceinline__ float bf2f(bf16_t h) { return __uint_as_float(((unsigned)h) << 16); }
__device__ __forceinline__ unsigned pk2(float a, float b) { return (unsigned)f2bf(a) | ((unsigned)f2bf(b) << 16); }
__device__ __forceinline__ bf16_t u4e(const uint4& v, int i) { const unsigned w = (i >> 1) == 0 ? v.x : (i >> 1) == 1 ? v.y : (i >> 1) == 2 ? v.z : v.w; return (bf16_t)((i & 1) ? (w >> 16) : (w & 0xffffu)); }
__device__ __forceinline__ bf16_t u2e(const uint2& v, int i) { const unsigned w = (i >> 1) == 0 ? v.x : v.y; return (bf16_t)((i & 1) ? (w >> 16) : (w & 0xffffu)); }
#define DPP_ADD(v, ctrl) ((v) + __builtin_bit_cast(float, __builtin_amdgcn_update_dpp(0, __builtin_bit_cast(int, (v)), (ctrl), 0xF, 0xF, true)))
__device__ __forceinline__ float row16_sum(float v) { v = DPP_ADD(v, 0xB1); v = DPP_ADD(v, 0x4E); v = DPP_ADD(v, 0x141); v = DPP_ADD(v, 0x140); return v; }
__device__ __forceinline__ float siluf(float v) { return v * __builtin_amdgcn_rcpf(1.f + __expf(-v)); }
__device__ __forceinline__ void fast_sincos(float x, float& s, float& c) {
    float k = rintf(x * 0.15915494309189535f);
    float r = fmaf(-k, 6.28125f, x); r = fmaf(-k, 1.9353071795864769e-3f, r);
    s = __sinf(r); c = __cosf(r);
}
__device__ __forceinline__ float2 cmul(float2 a, float2 b) { return make_float2(a.x * b.x - a.y * b.y, a.x * b.y + a.y * b.x); }
__device__ __forceinline__ float2 cadd(float2 a, float2 b) { return make_float2(a.x + b.x, a.y + b.y); }
__device__ __forceinline__ float2 csub(float2 a, float2 b) { return make_float2(a.x - b.x, a.y - b.y); }
__device__ __forceinline__ f32x4 mfma16(bf16x8 a, bf16x8 b, f32x4 c) { return __builtin_amdgcn_mfma_f32_16x16x32_bf16(a, b, c, 0, 0, 0); }

template <bool SPLIT = false, class Epi>
__device__ __forceinline__ void gemm_phase(const bf16_t* __restrict__ A, int lda, const bf16_t* __restrict__ Bt, int ldb, int M, int N, int K, const Epi& epi, unsigned char* smem) {
    int tid = threadIdx.x; asm volatile("" : "+v"(tid));
    const int lane = tid & 63, w = tid >> 6, wm = w >> 1, wn = w & 1;
    const int nN = N / 128, ntiles = (M / 256) * nN, nk = K / 64;
    bf16_t* As = (bf16_t*)smem;
    bf16_t* Bs = As + 2 * 256 * 64;
    const int lr = tid >> 3, lc = (tid & 7) * 8;
    const int fr = lane & 15, fq = lane >> 4;
    const int xcd_ = blockIdx.x & 7, jl_ = blockIdx.x >> 3, nbl_ = gridDim.x >> 3;
    const int tbeg_ = (int)(((long)ntiles * xcd_) >> 3), tend_ = (int)(((long)ntiles * (xcd_ + 1)) >> 3);
    const int len_ = tend_ - tbeg_; const int full_ = SPLIT ? (len_ / nbl_) * nbl_ : len_; const int tail_ = len_ - full_;
    int parts_ = 1;
    if (SPLIT && tail_ > 0) { const int lim = (nbl_ / tail_) < (nk >> 1) ? (nbl_ / tail_) : (nk >> 1); while (parts_ * 2 <= lim) parts_ *= 2; }
#define G_ITEM(IT, TILE, KB, NKK, ATOM, OK) { OK = true; KB = 0; NKK = nk; ATOM = false; TILE = 0; \
        if ((IT) < full_) TILE = tbeg_ + (IT); \
        else if (SPLIT && parts_ > 1 && (IT) - full_ < tail_ * parts_) { const int e_ = (IT) - full_; TILE = tbeg_ + full_ + e_ / parts_; NKK = nk / parts_; KB = (e_ % parts_) * NKK; ATOM = true; } \
        else if ((IT) < len_ && parts_ == 1) TILE = tbeg_ + (IT); \
        else OK = false; }
    uint4 pa0, pa1, pa2, pa3, pb0, pb1;
    uint4 qa0, qa1, qa2, qa3, qb0, qb1;
    bool primed_ = false;
    for (int it = jl_; ; it += nbl_) {
        int tile, kb_, nkk; bool atom_, ok_;
        G_ITEM(it, tile, kb_, nkk, atom_, ok_)
        if (!ok_) break;
        const int tm = tile / nN, tn = tile % nN;
        const bf16_t* Ag = A + (size_t)(tm * 256 + lr) * lda + lc + kb_ * 64;
        const bf16_t* Bg = Bt + (size_t)(tn * 128 + lr) * ldb + lc + kb_ * 64;
        int ntile_, nkb_, nnkk_; bool natom_, nok_;
        G_ITEM(it + nbl_, ntile_, nkb_, nnkk_, natom_, nok_)
        (void)natom_; (void)nnkk_;
        const bf16_t* Agn = A + (size_t)((ntile_ / nN) * 256 + lr) * lda + lc + nkb_ * 64;
        const bf16_t* Bgn = Bt + (size_t)((ntile_ % nN) * 128 + lr) * ldb + lc + nkb_ * 64;
        f32x4 acc[4][4];
#pragma unroll
        for (int i = 0; i < 4; ++i)
#pragma unroll
            for (int j = 0; j < 4; ++j) acc[i][j] = (f32x4){0.f, 0.f, 0.f, 0.f};
#define G_LOADN(P, kt_) { const bf16_t* ag = Agn + (kt_) * 64; const bf16_t* bg = Bgn + (kt_) * 64; \
    P##a0 = *(const uint4*)(ag); P##a1 = *(const uint4*)(ag + (size_t)64 * lda); P##a2 = *(const uint4*)(ag + (size_t)128 * lda); P##a3 = *(const uint4*)(ag + (size_t)192 * lda); \
    P##b0 = *(const uint4*)(bg); P##b1 = *(const uint4*)(bg + (size_t)64 * ldb); }
#define G_LOAD(P, kt_) { const bf16_t* ag = Ag + (kt_) * 64; const bf16_t* bg = Bg + (kt_) * 64; \
    P##a0 = *(const uint4*)(ag); P##a1 = *(const uint4*)(ag + (size_t)64 * lda); P##a2 = *(const uint4*)(ag + (size_t)128 * lda); P##a3 = *(const uint4*)(ag + (size_t)192 * lda); \
    P##b0 = *(const uint4*)(bg); P##b1 = *(const uint4*)(bg + (size_t)64 * ldb); }
#define G_STORE(P, buf_) { const int lcs = ((tid & 7) ^ ((tid >> 4) & 7)) * 8; bf16_t* ad = As + (buf_) * 256 * 64 + lr * 64 + lcs; bf16_t* bd = Bs + (buf_) * 128 * 64 + lr * 64 + lcs; \
    *(uint4*)(ad) = P##a0; *(uint4*)(ad + 64 * 64) = P##a1; *(uint4*)(ad + 128 * 64) = P##a2; *(uint4*)(ad + 192 * 64) = P##a3; \
    *(uint4*)(bd) = P##b0; *(uint4*)(bd + 64 * 64) = P##b1; }
#define G_MFMA16(a0, a1, a2, a3, b0, b1, b2, b3) { __builtin_amdgcn_s_setprio(1); \
        acc[0][0] = mfma16(a0, b0, acc[0][0]); acc[0][1] = mfma16(a0, b1, acc[0][1]); acc[0][2] = mfma16(a0, b2, acc[0][2]); acc[0][3] = mfma16(a0, b3, acc[0][3]); \
        acc[1][0] = mfma16(a1, b0, acc[1][0]); acc[1][1] = mfma16(a1, b1, acc[1][1]); acc[1][2] = mfma16(a1, b2, acc[1][2]); acc[1][3] = mfma16(a1, b3, acc[1][3]); \
        acc[2][0] = mfma16(a2, b0, acc[2][0]); acc[2][1] = mfma16(a2, b1, acc[2][1]); acc[2][2] = mfma16(a2, b2, acc[2][2]); acc[2][3] = mfma16(a2, b3, acc[2][3]); \
        acc[3][0] = mfma16(a3, b0, acc[3][0]); acc[3][1] = mfma16(a3, b1, acc[3][1]); acc[3][2] = mfma16(a3, b2, acc[3][2]); acc[3][3] = mfma16(a3, b3, acc[3][3]); \
        __builtin_amdgcn_s_setprio(0); }
#define G_PRE(buf_) \
    const bf16_t* as_ = As + (buf_) * 256 * 64 + (wm * 64 + fr) * 64; const bf16_t* bs_ = Bs + (buf_) * 128 * 64 + (wn * 64 + fr) * 64; \
    const int so0_ = ((fq) ^ (fr >> 1)) << 3, so1_ = ((4 | fq) ^ (fr >> 1)) << 3; \
    const bf16x8 fa0 = *(const bf16x8*)(as_ + so0_), fa1 = *(const bf16x8*)(as_ + 16 * 64 + so0_), fa2 = *(const bf16x8*)(as_ + 32 * 64 + so0_), fa3 = *(const bf16x8*)(as_ + 48 * 64 + so0_); \
    const bf16x8 fb0 = *(const bf16x8*)(bs_ + so0_), fb1 = *(const bf16x8*)(bs_ + 16 * 64 + so0_), fb2 = *(const bf16x8*)(bs_ + 32 * 64 + so0_), fb3 = *(const bf16x8*)(bs_ + 48 * 64 + so0_);
#define G_MID() G_MFMA16(fa0, fa1, fa2, fa3, fb0, fb1, fb2, fb3)
#define G_RD1() \
    const bf16x8 ga0 = *(const bf16x8*)(as_ + so1_), ga1 = *(const bf16x8*)(as_ + 16 * 64 + so1_), ga2 = *(const bf16x8*)(as_ + 32 * 64 + so1_), ga3 = *(const bf16x8*)(as_ + 48 * 64 + so1_); \
    const bf16x8 gb0 = *(const bf16x8*)(bs_ + so1_), gb1 = *(const bf16x8*)(bs_ + 16 * 64 + so1_), gb2 = *(const bf16x8*)(bs_ + 32 * 64 + so1_), gb3 = *(const bf16x8*)(bs_ + 48 * 64 + so1_);
#define G_POST() G_MFMA16(ga0, ga1, ga2, ga3, gb0, gb1, gb2, gb3)
        if (!primed_) { G_LOAD(p, 0) G_LOAD(q, 1) }
        __syncthreads();
        G_STORE(p, 0)
        if (2 < nkk) G_LOAD(p, 2) else if (nok_) G_LOADN(p, 0)
        for (int kt = 0; kt < nkk; kt += 2) {
            __syncthreads();
            {
                G_PRE(0)
                G_MID()
                G_RD1()
                G_STORE(q, 1)
                if (kt + 3 < nkk) G_LOAD(q, kt + 3) else if (nok_) G_LOADN(q, 1)
                G_POST()
            }
            __syncthreads();
            {
                G_PRE(1)
                G_MID()
                G_RD1()
                if (kt + 2 < nkk) { G_STORE(p, 0) if (kt + 4 < nkk) G_LOAD(p, kt + 4) else if (nok_) G_LOADN(p, 0) }
                G_POST()
            }
        }
        primed_ = nok_;
        { int ln = lane; asm volatile("" : "+v"(ln));
          if constexpr (SPLIT) { if (atom_) epi.atom(acc, tm * 256 + wm * 64, tn * 128 + wn * 64, ln); else epi(acc, tm * 256 + wm * 64, tn * 128 + wn * 64, ln); }
          else epi(acc, tm * 256 + wm * 64, tn * 128 + wn * 64, ln); }
    }
}

__device__ __forceinline__ void epi_store_cols_bf16(f32x4 (&acc)[4][4], bf16_t* __restrict__ dstT, size_t ldT, int lane) {
    extern __shared__ __attribute__((aligned(16))) unsigned char smem_e[];
    bf16_t* st = (bf16_t*)(smem_e + 98304 + (threadIdx.x >> 6) * 4608);
    const int fr = lane & 15, fq = lane >> 4;
#pragma unroll
    for (int half = 0; half < 2; ++half) {
#pragma unroll
        for (int n2 = 0; n2 < 2; ++n2)
#pragma unroll
            for (int mt = 0; mt < 4; ++mt) { const f32x4 a = acc[mt][half * 2 + n2]; uint2 pk; pk.x = pk2(a[0], a[1]); pk.y = pk2(a[2], a[3]); *(uint2*)(st + (n2 * 16 + fr) * 72 + mt * 16 + fq * 4) = pk; }
#pragma unroll
        for (int i = 0; i < 4; ++i) { const int pc = lane + 64 * i; const int c = pc >> 3, ch = pc & 7;
            *(uint4*)(dstT + (size_t)(half * 32 + c) * ldT + ch * 8) = *(const uint4*)(st + c * 72 + ch * 8); }
    }
}

struct EpiWin {
    bf16_t *u, *qr, *kr, *vT;
    __device__ __forceinline__ void operator()(f32x4 (&acc)[4][4], int row0, int col0, int lane) const {
        const int fr = lane & 15, fq = lane >> 4;
        if (col0 < 1536) {
#pragma unroll
            for (int mt = 0; mt < 4; ++mt)
#pragma unroll
                for (int nt = 0; nt < 4; ++nt)
#pragma unroll
                    for (int j = 0; j < 4; ++j) u[(size_t)(row0 + mt * 16 + fq * 4 + j) * 1536 + col0 + nt * 16 + fr] = f2bf(acc[mt][nt][j]);
        } else if (col0 < 2176) {
            const bool isq = col0 < 2048;
            const int hc = isq ? (col0 - 1536) : (col0 - 2048);
            bf16_t* dst = isq ? qr : kr; const int ld = isq ? 512 : 128; const float sc = isq ? 0.125f : 1.f;
            const float inv = exp2f(-(float)fr * (13.287712379549449f / 16.f));
#pragma unroll
            for (int mt = 0; mt < 4; ++mt)
#pragma unroll
                for (int j = 0; j < 4; ++j) {
                    const int row = row0 + mt * 16 + fq * 4 + j; const int s = row % RB;
                    float v0 = acc[mt][0][j], v1 = acc[mt][1][j], v2 = acc[mt][2][j], v3 = acc[mt][3][j];
                    if (s < SEQ) {
                        float sr, cr, sc2, cc; fast_sincos((float)(s >> 6) * inv, sr, cr); fast_sincos((float)(s & 63) * inv, sc2, cc);
                        const float a0 = v0 * cr - v1 * sr, a1 = v1 * cr + v0 * sr, a2 = v2 * cc - v3 * sc2, a3 = v3 * cc + v2 * sc2;
                        v0 = a0; v1 = a1; v2 = a2; v3 = a3;
                    }
                    bf16_t* o = dst + (size_t)row * ld + hc + fr;
                    o[0] = f2bf(v0 * sc); o[16] = f2bf(v1 * sc); o[32] = f2bf(v2 * sc); o[48] = f2bf(v3 * sc);
                }
        } else {
            const int hc = col0 - 2176;
            epi_store_cols_bf16(acc, vT + (size_t)hc * MROWS + row0, (size_t)MROWS, lane);
        }
    }
};
struct EpiRes0 {
    const float *srcl, *srcc; float *dstl, *dstc; const float* mod; int goff;
    __device__ __forceinline__ void operator()(f32x4 (&acc)[4][4], int row0, int col0, int lane) const {
        const int fr = lane & 15, fq = lane >> 4;
        const int b = row0 / RB; const int i0 = row0 % RB; const bool lat = i0 < SEQ;
        const float* g = mod + (lat ? b : 2) * 6144 + goff;
        float gv[4];
#pragma unroll
        for (int nt = 0; nt < 4; ++nt) gv[nt] = g[col0 + nt * 16 + fr];
        const size_t base0 = lat ? ((size_t)(b * SEQ + i0 + fq * 4) * D) : ((size_t)(b * CTXL + i0 - SEQ + fq * 4) * D);
        const float* s0 = (lat ? srcl : srcc) + base0 + col0 + fr; float* d0 = (lat ? dstl : dstc) + base0 + col0 + fr;
#pragma unroll
        for (int mt = 0; mt < 4; ++mt) {
            float sv[4][4];
#pragma unroll
            for (int j = 0; j < 4; ++j)
#pragma unroll
                for (int nt = 0; nt < 4; ++nt) sv[j][nt] = s0[(size_t)(mt * 16 + j) * D + nt * 16];
#pragma unroll
            for (int j = 0; j < 4; ++j)
#pragma unroll
                for (int nt = 0; nt < 4; ++nt) d0[(size_t)(mt * 16 + j) * D + nt * 16] = sv[j][nt] + gv[nt] * acc[mt][nt][j];
        }
    }
    __device__ __forceinline__ void atom(f32x4 (&acc)[4][4], int row0, int col0, int lane) const {
        const int fr = lane & 15, fq = lane >> 4;
        const int b = row0 / RB; const int i0 = row0 % RB; const bool lat = i0 < SEQ;
        const float* g = mod + (lat ? b : 2) * 6144 + goff;
#pragma unroll
        for (int mt = 0; mt < 4; ++mt)
#pragma unroll
            for (int j = 0; j < 4; ++j) {
                const int i = i0 + mt * 16 + fq * 4 + j;
                const size_t base = lat ? ((size_t)(b * SEQ + i) * D) : ((size_t)(b * CTXL + i - SEQ) * D);
                float* d = (lat ? dstl : dstc) + base;
#pragma unroll
                for (int nt = 0; nt < 4; ++nt) { const int col = col0 + nt * 16 + fr; atomicAdd(&d[col], g[col] * acc[mt][nt][j]); }
            }
    }
};
struct EpiRelu2 {
    bf16_t* h; int ld;
    __device__ __forceinline__ void operator()(f32x4 (&acc)[4][4], int row0, int col0, int lane) const {
        const int fr = lane & 15, fq = lane >> 4;
#pragma unroll
        for (int mt = 0; mt < 4; ++mt)
#pragma unroll
            for (int nt = 0; nt < 4; ++nt)
#pragma unroll
                for (int j = 0; j < 4; ++j) { float v = fmaxf(acc[mt][nt][j], 0.f); h[(size_t)(row0 + mt * 16 + fq * 4 + j) * ld + col0 + nt * 16 + fr] = f2bf(v * v); }
    }
};
struct EpiResLat {
    float* dst; const float* mod; int goff; int rowoff;
    __device__ __forceinline__ void operator()(f32x4 (&acc)[4][4], int row0, int col0, int lane) const {
        const int fr = lane & 15, fq = lane >> 4;
        const int r0 = row0 + rowoff; const float* g = mod + (r0 / SEQ) * 6144 + goff;
        float gv[4];
#pragma unroll
        for (int nt = 0; nt < 4; ++nt) gv[nt] = g[col0 + nt * 16 + fr];
        float* d0 = dst + (size_t)(r0 + fq * 4) * D + col0 + fr;
#pragma unroll
        for (int mt = 0; mt < 4; ++mt) {
            float sv[4][4];
#pragma unroll
            for (int j = 0; j < 4; ++j)
#pragma unroll
                for (int nt = 0; nt < 4; ++nt) sv[j][nt] = d0[(size_t)(mt * 16 + j) * D + nt * 16];
#pragma unroll
            for (int j = 0; j < 4; ++j)
#pragma unroll
                for (int nt = 0; nt < 4; ++nt) d0[(size_t)(mt * 16 + j) * D + nt * 16] = sv[j][nt] + gv[nt] * acc[mt][nt][j];
        }
    }
};
struct EpiRet {
    bf16_t *q1, *kz, *v1, *sg; const float* lrate;
    __device__ __forceinline__ void operator()(f32x4 (&acc)[4][4], int row0, int col0, int lane) const {
        const int fr = lane & 15, fq = lane >> 4;
        if (col0 < 2048) {
            const bool isq = col0 < 1024;
            if (isq && row0 >= SEQ) return;
            const int cc = isq ? col0 : col0 - 1024; const int h = cc >> 8, nb = cc & 255;
            const float lgf = -__expf(lrate[h]), lgb = -__expf(lrate[4 + h]);
            extern __shared__ __attribute__((aligned(16))) unsigned char smem_k[];
            bf16_t* kst = (bf16_t*)(smem_k + 98304 + (threadIdx.x >> 6) * 4608);
            const bool latT = row0 < SEQ;
            const int lr00 = row0 + fq * 4;
            const float pf0 = latT ? (float)(256 + lr00) : (float)(lr00 - SEQ);
            const float Cc = latT ? 8703.f : 255.f;
            const int a0 = lr00 & 127;
            const float ef0 = 0.0625f * __expf((float)(127 - a0) * lgf), eb0 = 0.0625f * __expf((float)a0 * lgb);
            const float efs = __expf(-lgf), ebs = __expf(lgb), efs16 = __expf(-16.f * lgf), ebs16 = __expf(16.f * lgb);
#pragma unroll
            for (int pr = 0; pr < 2; ++pr) {
                const int f = ((nb + pr * 32) >> 5) * 16 + fr;
                const float inv = exp2f(-(float)f * (13.287712379549449f / 127.f));
                float s1, c1, s16, c16, sC, cC, sm, cm;
                fast_sincos(inv, s1, c1); fast_sincos(16.f * inv, s16, c16); fast_sincos(Cc * inv, sC, cC); fast_sincos(pf0 * inv, sm, cm);
                float efm = ef0, ebm = eb0;
                uint2 kbp1[4], kbp2[4];
#pragma unroll
                for (int mt = 0; mt < 4; ++mt) { kbp1[mt] = make_uint2(0, 0); kbp2[mt] = kbp1[mt]; }
#pragma unroll
                for (int mt = 0; mt < 4; ++mt) {
                    float of1[4], of2[4], ob1[4], ob2[4];
                    float sf = sm, cf = cm, mf = efm, mb = ebm;
#pragma unroll
                    for (int j = 0; j < 4; ++j) {
                        const float x1 = acc[mt][2 * pr][j], x2 = acc[mt][2 * pr + 1][j];
                        const float cb = cC * cf + sC * sf, sb = sC * cf - cC * sf;
                        const float wf = isq ? 1.f : mf, wb = isq ? 1.f : mb;
                        of1[j] = (x1 * cf - x2 * sf) * wf; of2[j] = (x2 * cf + x1 * sf) * wf;
                        ob1[j] = (x1 * cb - x2 * sb) * wb; ob2[j] = (x2 * cb + x1 * sb) * wb;
                        const float cn = cf * c1 - sf * s1, sn = sf * c1 + cf * s1; cf = cn; sf = sn;
                        mf *= efs; mb *= ebs;
                    }
                    { const float cn = cm * c16 - sm * s16, sn = sm * c16 + cm * s16; cm = cn; sm = sn; efm *= efs16; ebm *= ebs16; }
                    const int lr0 = row0 + mt * 16 + fq * 4;
                    if (isq) {
#pragma unroll
                        for (int j = 0; j < 4; ++j) {
                            bf16_t* of = q1 + (size_t)(lr0 + j) * 1024 + h * 256 + f; bf16_t* ob = of + (size_t)SEQ * 1024;
                            of[0] = f2bf(of1[j]); of[128] = f2bf(of2[j]); ob[0] = f2bf(ob1[j]); ob[128] = f2bf(ob2[j]);
                        }
                    } else {
                        uint2 t;
                        t.x = pk2(of1[0], of1[1]); t.y = pk2(of1[2], of1[3]); *(uint2*)(kst + fr * 72 + mt * 16 + fq * 4) = t;
                        t.x = pk2(of2[0], of2[1]); t.y = pk2(of2[2], of2[3]); *(uint2*)(kst + (16 + fr) * 72 + mt * 16 + fq * 4) = t;
                        kbp1[mt].x = pk2(ob1[0], ob1[1]); kbp1[mt].y = pk2(ob1[2], ob1[3]); kbp2[mt].x = pk2(ob2[0], ob2[1]); kbp2[mt].y = pk2(ob2[2], ob2[3]);
                    }
                }
                if (!isq) {
                    const int f0 = ((nb + pr * 32) >> 5) * 16;
                    bf16_t* kdst = kz + (size_t)(h * 256 + f0) * RB + row0;
#pragma unroll
                    for (int i = 0; i < 4; ++i) { const int pc = lane + 64 * i; const int c = pc >> 3, ch = pc & 7;
                        *(uint4*)(kdst + (size_t)((c & 15) + (c >> 4) * 128) * RB + ch * 8) = *(const uint4*)(kst + c * 72 + ch * 8); }
#pragma unroll
                    for (int mt = 0; mt < 4; ++mt) { *(uint2*)(kst + fr * 72 + mt * 16 + fq * 4) = kbp1[mt]; *(uint2*)(kst + (16 + fr) * 72 + mt * 16 + fq * 4) = kbp2[mt]; }
                    kdst += (size_t)1024 * RB;
#pragma unroll
                    for (int i = 0; i < 4; ++i) { const int pc = lane + 64 * i; const int c = pc >> 3, ch = pc & 7;
                        *(uint4*)(kdst + (size_t)((c & 15) + (c >> 4) * 128) * RB + ch * 8) = *(const uint4*)(kst + c * 72 + ch * 8); }
                }
            }
        } else if (col0 < 4096) {
            const int vc = col0 - 2048;
            epi_store_cols_bf16(acc, v1 + (size_t)vc * RB + row0, (size_t)RB, lane);
        } else {
            if (row0 >= SEQ) return;
            const int dir = col0 >= 6144; const int gc = col0 - 4096 - dir * 2048;
            bf16_t* dst = sg + (size_t)dir * SEQ * 2048;
#pragma unroll
            for (int mt = 0; mt < 4; ++mt)
#pragma unroll
                for (int nt = 0; nt < 4; ++nt)
#pragma unroll
                    for (int j = 0; j < 4; ++j) dst[(size_t)(row0 + mt * 16 + fq * 4 + j) * 2048 + gc + nt * 16 + fr] = f2bf(siluf(acc[mt][nt][j]));
        }
    }
};

__device__ __forceinline__ void convert_w(const float* __restrict__ src, bf16_t* __restrict__ dst, int K, int N, int unit, bool perm, unsigned char* smem) {
    float* t = (float*)smem;
    const int tid = threadIdx.x; const int nkb = K / 64; const int kb = unit % nkb, nb = unit / nkb;
    __syncthreads();
#pragma unroll
    for (int i = 0; i < 2; ++i) {
        const int k = (tid >> 4) + 32 * i, n = (tid & 15) * 4;
        const float4 v = *(const float4*)(src + (size_t)(kb * 64 + k) * N + nb * 64 + n);
        t[k * 65 + n] = v.x; t[k * 65 + n + 1] = v.y; t[k * 65 + n + 2] = v.z; t[k * 65 + n + 3] = v.w;
    }
    __syncthreads();
    const int n = tid >> 3, k0 = (tid & 7) * 8;
    int no = nb * 64 + n;
    if (perm && no < 2048) { const int hb = no & ~255, d = no & 255; const int half = d >> 7, ip = d & 127; no = hb + (ip >> 4) * 32 + half * 16 + (ip & 15); }
    uint4 o;
    o.x = pk2(t[(k0 + 0) * 65 + n], t[(k0 + 1) * 65 + n]); o.y = pk2(t[(k0 + 2) * 65 + n], t[(k0 + 3) * 65 + n]);
    o.z = pk2(t[(k0 + 4) * 65 + n], t[(k0 + 5) * 65 + n]); o.w = pk2(t[(k0 + 6) * 65 + n], t[(k0 + 7) * 65 + n]);
    *(uint4*)(dst + (size_t)no * K + kb * 64 + k0) = o;
}

__device__ __forceinline__ void mod_unit(const Params& p, int unit, unsigned char* smem) {
    float* sc = (float*)smem;
    float* red = sc + 3072;
    const int tid = threadIdx.x, lane = tid & 63, w = tid >> 6;
    const int layer = unit / 96, n0 = (unit % 96) * 64;
    __syncthreads();
    for (int i = tid; i < 3072; i += NT) { const int v = i >> 10, k = i & 1023; const float cv = v < 2 ? p.c[v * 1024 + k] : p.c_ctx[k]; sc[i] = siluf(cv); }
    __syncthreads();
    const float* W = p.ada_w + (size_t)layer * 1024 * 6144 + n0 + lane;
    float a0 = 0.f, a1 = 0.f, a2 = 0.f;
#pragma unroll 8
    for (int k = w * 128; k < w * 128 + 128; ++k) { const float wv = W[(size_t)k * 6144]; a0 += sc[k] * wv; a1 += sc[1024 + k] * wv; a2 += sc[2048 + k] * wv; }
    red[(w * 3 + 0) * 64 + lane] = a0; red[(w * 3 + 1) * 64 + lane] = a1; red[(w * 3 + 2) * 64 + lane] = a2;
    __syncthreads();
    if (tid < 192) {
        const int v = tid >> 6; float s = 0.f;
        for (int ww = 0; ww < 8; ++ww) s += red[(ww * 3 + v) * 64 + lane];
        float* mod = (float*)(p.ws + OFF_MOD);
        mod[(layer * 3 + v) * 6144 + n0 + lane] = s + p.ada_b[layer * 6144 + n0 + lane];
    }
}

__device__ __forceinline__ void filter_unit(const Params& p, int L, int j0, float* hT, float* pn, unsigned char* smem) {
    float* zf = (float*)smem;
    float* h1 = zf + 32 * 36;
    float* h2 = h1 + 32 * 64;
    float* w1s = h2 + 32 * 64;
    float* w2s = w1s + 33 * 64;
    float* bfs = w2s + 64 * 64;
    const int tid = threadIdx.x;
    __syncthreads();
    for (int i = tid; i < 33 * 64; i += NT) w1s[i] = p.hy_w1[i];
    for (int i = tid; i < 64 * 64; i += NT) w2s[i] = p.hy_w2[i];
    if (tid < 64) { bfs[tid] = p.hy_b1[tid]; bfs[64 + tid] = p.hy_b2[tid]; bfs[128 + tid] = p.hy_freq[tid]; }
    for (int i = tid; i < 32 * 33; i += NT) {
        const int r = i / 33, f = i % 33; const float t = (float)(j0 + r) / (float)L; float v;
        if (f == 0) v = t;
        else { const int kb = (f - 1) & 15; const float band = 1e-4f + (float)kb * ((15.f - 1e-4f) / 15.f); const float ang = 6.283185307179586f * t * band; float s, c; fast_sincos(ang, s, c); v = (f <= 16) ? c : -s; }
        zf[r * 36 + f] = v;
    }
    __syncthreads();
    {
        const int r = tid >> 4, o0 = (tid & 15) * 4;
        float a0 = bfs[o0], a1 = bfs[o0 + 1], a2 = bfs[o0 + 2], a3 = bfs[o0 + 3];
#pragma unroll 11
        for (int f = 0; f < 33; ++f) { const float z = zf[r * 36 + f]; const float4 w = *(const float4*)(w1s + f * 64 + o0); a0 += z * w.x; a1 += z * w.y; a2 += z * w.z; a3 += z * w.w; }
        float s_, c_;
        fast_sincos(bfs[128 + o0] * a0, s_, c_); h1[r * 64 + o0] = s_; fast_sincos(bfs[128 + o0 + 1] * a1, s_, c_); h1[r * 64 + o0 + 1] = s_;
        fast_sincos(bfs[128 + o0 + 2] * a2, s_, c_); h1[r * 64 + o0 + 2] = s_; fast_sincos(bfs[128 + o0 + 3] * a3, s_, c_); h1[r * 64 + o0 + 3] = s_;
    }
    __syncthreads();
    {
        const int r = tid >> 4, o0 = (tid & 15) * 4;
        float a0 = bfs[64 + o0], a1 = bfs[64 + o0 + 1], a2 = bfs[64 + o0 + 2], a3 = bfs[64 + o0 + 3];
#pragma unroll 16
        for (int f = 0; f < 64; ++f) { const float z = h1[r * 64 + f]; const float4 w = *(const float4*)(w2s + f * 64 + o0); a0 += z * w.x; a1 += z * w.y; a2 += z * w.z; a3 += z * w.w; }
        float s_, c_;
        fast_sincos(bfs[128 + o0] * a0, s_, c_); h2[r * 64 + o0] = s_; fast_sincos(bfs[128 + o0 + 1] * a1, s_, c_); h2[r * 64 + o0 + 1] = s_;
        fast_sincos(bfs[128 + o0 + 2] * a2, s_, c_); h2[r * 64 + o0 + 2] = s_; fast_sincos(bfs[128 + o0 + 3] * a3, s_, c_); h2[r * 64 + o0 + 3] = s_;
    }
    __syncthreads();
    for (int cc = 0; cc < 2; ++cc) {
        const int col = tid + cc * 512;
        float wr[64];
#pragma unroll
        for (int k = 0; k < 64; ++k) wr[k] = p.hy_w3[k * 1024 + col];
        const float dec = fabsf(p.hy_decay[col]); float ss = 0.f;
        float* dst = hT + (size_t)col * L + j0;
#pragma unroll 1
        for (int rb = 0; rb < 32; rb += 4) {
            float a0 = 0.f, a1 = 0.f, a2 = 0.f, a3 = 0.f;
#pragma unroll
            for (int k4 = 0; k4 < 64; k4 += 4) {
                const float4 h0 = *(const float4*)(h2 + (rb + 0) * 64 + k4), h1v = *(const float4*)(h2 + (rb + 1) * 64 + k4), h2v = *(const float4*)(h2 + (rb + 2) * 64 + k4), h3v = *(const float4*)(h2 + (rb + 3) * 64 + k4);
                a0 += h0.x * wr[k4] + h0.y * wr[k4 + 1] + h0.z * wr[k4 + 2] + h0.w * wr[k4 + 3];
                a1 += h1v.x * wr[k4] + h1v.y * wr[k4 + 1] + h1v.z * wr[k4 + 2] + h1v.w * wr[k4 + 3];
                a2 += h2v.x * wr[k4] + h2v.y * wr[k4 + 1] + h2v.z * wr[k4 + 2] + h2v.w * wr[k4 + 3];
                a3 += h3v.x * wr[k4] + h3v.y * wr[k4 + 1] + h3v.z * wr[k4 + 2] + h3v.w * wr[k4 + 3];
            }
            const float invL = 1.f / (float)L;
            a0 *= __expf(-(float)(j0 + rb) * invL * dec); a1 *= __expf(-(float)(j0 + rb + 1) * invL * dec); a2 *= __expf(-(float)(j0 + rb + 2) * invL * dec); a3 *= __expf(-(float)(j0 + rb + 3) * invL * dec);
            if (!(cc == 1 && j0 + rb == 0)) ss += a0 * a0;
            ss += a1 * a1 + a2 * a2 + a3 * a3;
            *(float4*)(dst + rb) = make_float4(a0, a1, a2, a3);
        }
        pn[col] = ss;
    }
}

__device__ __forceinline__ void normmod_row(const float* __restrict__ src, const float* __restrict__ g, const float* __restrict__ sh, const float* __restrict__ sc, bf16_t* __restrict__ dst, int lane) {
    float4 v[4]; float ss = 0.f;
#pragma unroll
    for (int i = 0; i < 4; ++i) { v[i] = *(const float4*)(src + i * 256 + lane * 4); ss += v[i].x * v[i].x + v[i].y * v[i].y + v[i].z * v[i].z + v[i].w * v[i].w; }
#pragma unroll
    for (int o = 32; o >= 1; o >>= 1) ss += __shfl_xor(ss, o);
    const float rs = rsqrtf(ss * (1.f / 1024.f) + 1e-6f);
#pragma unroll
    for (int i = 0; i < 4; ++i) {
        const int c0 = i * 256 + lane * 4;
        const float4 gg = *(const float4*)(g + c0), s1 = *(const float4*)(sh + c0), s2 = *(const float4*)(sc + c0);
        uint2 o; o.x = pk2(v[i].x * rs * gg.x * (1.f + s2.x) + s1.x, v[i].y * rs * gg.y * (1.f + s2.y) + s1.y);
        o.y = pk2(v[i].z * rs * gg.z * (1.f + s2.z) + s1.z, v[i].w * rs * gg.w * (1.f + s2.w) + s1.w);
        *(uint2*)(dst + c0) = o;
    }
}

struct RowMap {
    const float* lat; const float* ctx; int mode; int b;
    __device__ __forceinline__ const float* src(int r, int& vidx) const {
        if (mode == 2) { vidx = r / SEQ; return lat + (size_t)r * D; }
        const int bb = mode == 0 ? r / RB : b; const int i = mode == 0 ? r % RB : r;
        if (i < SEQ) { vidx = bb; return lat + (size_t)(bb * SEQ + i) * D; }
        vidx = 2; return ctx + (size_t)(bb * CTXL + i - SEQ) * D;
    }
};
__device__ __forceinline__ void normmod_phase(int M, const RowMap& rm, const float* __restrict__ g, const float* __restrict__ modl, int sh_off, int sc_off, bf16_t* __restrict__ dst, int gw, int nw, int lane) {
    const int per = (M + nw - 1) / nw; const int r0 = gw * per; const int r1 = (r0 + per < M) ? r0 + per : M;
    if (r0 >= r1) return;
    int curv = -1; float4 ca[4], cb[4];
    int vidx; const float* s = rm.src(r0, vidx);
    float4 v[4];
#pragma unroll
    for (int i = 0; i < 4; ++i) v[i] = *(const float4*)(s + i * 256 + lane * 4);
#pragma unroll 1
    for (int r = r0; r < r1; ++r) {
        float4 nv[4]; int nvidx = vidx;
        { const int rn = (r + 1 < r1) ? r + 1 : r; const float* ns = rm.src(rn, nvidx);
#pragma unroll
            for (int i = 0; i < 4; ++i) nv[i] = *(const float4*)(ns + i * 256 + lane * 4); }
        if (vidx != curv) {
            curv = vidx; const float* mv = modl + vidx * 6144;
#pragma unroll
            for (int i = 0; i < 4; ++i) { const int c0 = i * 256 + lane * 4; const float4 gg = *(const float4*)(g + c0), s1 = *(const float4*)(mv + sh_off + c0), s2 = *(const float4*)(mv + sc_off + c0);
                ca[i] = make_float4(gg.x * (1.f + s2.x), gg.y * (1.f + s2.y), gg.z * (1.f + s2.z), gg.w * (1.f + s2.w)); cb[i] = s1; }
        }
        float ss = 0.f;
#pragma unroll
        for (int i = 0; i < 4; ++i) ss += v[i].x * v[i].x + v[i].y * v[i].y + v[i].z * v[i].z + v[i].w * v[i].w;
#pragma unroll
        for (int o = 32; o >= 1; o >>= 1) ss += __shfl_xor(ss, o);
        const float rs = rsqrtf(ss * (1.f / 1024.f) + 1e-6f);
        bf16_t* d = dst + (size_t)r * D;
#pragma unroll
        for (int i = 0; i < 4; ++i) {
            uint2 o; o.x = pk2(v[i].x * rs * ca[i].x + cb[i].x, v[i].y * rs * ca[i].y + cb[i].y); o.y = pk2(v[i].z * rs * ca[i].z + cb[i].z, v[i].w * rs * ca[i].w + cb[i].w);
            *(uint2*)(d + i * 256 + lane * 4) = o;
        }
#pragma unroll
        for (int i = 0; i < 4; ++i) v[i] = nv[i];
        vidx = nvidx;
    }
}

__device__ __forceinline__ void fft_fwd(float2* X, const float2* __restrict__ tw, int tid) {
    for (int h = 8192; h >= 2; h >>= 2) {
        const int q = h >> 1, tsh = 8192 / h; const int lq = 31 - __clz(q);
        const bool same_ = q <= NT; const int off0_ = tid & (q - 1);
        float2 w1h = make_float2(1.f, 0.f), w2h = w1h;
        if (same_) { w1h = tw[off0_ * tsh]; w2h = tw[off0_ * tsh * 2]; }
        for (int g = tid; g < 4096; g += NT) {
            const int blk = g >> lq, off = g & (q - 1); const int base = blk * 2 * h + off;
            const float2 a = X[base], b = X[base + q], c = X[base + 2 * q], d = X[base + 3 * q];
            float2 w1 = w1h, w2 = w2h;
            if (!same_) { w1 = tw[off * tsh]; w2 = tw[off * tsh * 2]; }
            const float2 a1 = cadd(a, c), c1 = cmul(csub(a, c), w1);
            const float2 b1 = cadd(b, d); const float2 t = csub(b, d); const float2 d1 = cmul(make_float2(t.y, -t.x), w1);
            X[base] = cadd(a1, b1); X[base + q] = cmul(csub(a1, b1), w2); X[base + 2 * q] = cadd(c1, d1); X[base + 3 * q] = cmul(csub(c1, d1), w2);
        }
        __syncthreads();
    }
}
__device__ __forceinline__ void fft_inv(float2* X, const float2* __restrict__ tw, int tid) {
    for (int h = 2; h <= 8192; h <<= 2) {
        const int q = h >> 1, tsh = 8192 / h; const int lq = 31 - __clz(q);
        const bool same_ = q <= NT; const int off0_ = tid & (q - 1);
        float2 w1h = make_float2(1.f, 0.f), w2h = w1h;
        if (same_) { w1h = tw[off0_ * tsh]; w2h = tw[off0_ * tsh * 2]; }
        for (int g = tid; g < 4096; g += NT) {
            const int blk = g >> lq, off = g & (q - 1); const int base = blk * 2 * h + off;
            const float2 a = X[base], b = X[base + q], c = X[base + 2 * q], d = X[base + 3 * q];
            float2 w1 = w1h, w2 = w2h;
            if (!same_) { w1 = tw[off * tsh]; w2 = tw[off * tsh * 2]; }
            w1.y = -w1.y; w2.y = -w2.y;
            const float2 bb = cmul(b, w2), dd = cmul(d, w2);
            const float2 a1 = cadd(a, bb), b1 = csub(a, bb), c1 = cadd(c, dd), d1 = csub(c, dd);
            const float2 cc = cmul(c1, w1); const float2 t = cmul(d1, w1); const float2 d2 = make_float2(-t.y, t.x);
            X[base] = cadd(a1, cc); X[base + 2 * q] = csub(a1, cc); X[base + q] = cadd(b1, d2); X[base + 3 * q] = csub(b1, d2);
        }
        __syncthreads();
    }
}

__device__ __forceinline__ void attn_unit(const Params& p, int b, int kh, int half, int qrow0  , int nloc  , unsigned char* smem) {
    const bf16_t* qr = (const bf16_t*)(p.ws + OFF_QR); const bf16_t* kr = (const bf16_t*)(p.ws + OFF_KR); const bf16_t* vT = (const bf16_t*)(p.ws + OFF_VT);
    bf16_t* ao = (bf16_t*)(p.ws + OFF_AO);
    bf16_t* Ks = (bf16_t*)smem;
    bf16_t* Vs = Ks + 64 * 72;
    int tid = threadIdx.x; asm volatile("" : "+v"(tid));
    const int lane = tid & 63, w = tid >> 6, fr = lane & 15, fq = lane >> 4;
    const int g = half * 2 + (w >> 2), qq = w & 3, h = kh * 4 + g;
    const int myq0 = qrow0 + qq * 32;
    bf16x8 qf[2][2];
#pragma unroll
    for (int qt = 0; qt < 2; ++qt)
#pragma unroll
        for (int ks = 0; ks < 2; ++ks) qf[qt][ks] = *(const bf16x8*)(qr + (size_t)(myq0 + qt * 16 + fr) * 512 + h * 64 + ks * 32 + fq * 8);
    f32x4 o[2][4];
#pragma unroll
    for (int i = 0; i < 2; ++i)
#pragma unroll
        for (int j = 0; j < 4; ++j) o[i][j] = (f32x4){0.f, 0.f, 0.f, 0.f};
    const float sink = p.attn_sink[h];
    float m[2], l[2];
#pragma unroll
    for (int qt = 0; qt < 2; ++qt) { m[qt] = sink; l[qt] = 1.f; }
    int loc0 = 0, nlt = 0;
    if (nloc >= 0) { int lo = (nloc - 1) * 128; if (lo < 0) lo = 0; int hi = (nloc + 2) * 128; if (hi > SEQ) hi = SEQ; loc0 = lo; nlt = (hi - lo) / 64; }
    const int ntile = nlt + 4;
    const int sr_ = tid >> 3, sch_ = (tid & 7) * 8;
    uint4 kpre, vpre;
    { const int krow00 = nlt > 0 ? b * RB + loc0 : b * RB + SEQ;
      kpre = *(const uint4*)(kr + (size_t)(krow00 + sr_) * 128 + kh * 64 + sch_); vpre = *(const uint4*)(vT + (size_t)(kh * 64 + sr_) * MROWS + krow00 + sch_); }
#pragma unroll 1
    for (int t = 0; t < ntile; ++t) {
        const bool isloc = t < nlt;
        const int kpos0 = isloc ? loc0 + t * 64 : 0;
        __syncthreads();
        *(uint4*)(Ks + sr_ * 72 + sch_) = kpre; *(uint4*)(Vs + sr_ * 72 + sch_) = vpre;
        if (t + 1 < ntile) { const int t1 = t + 1; const int krow1 = t1 < nlt ? b * RB + loc0 + t1 * 64 : b * RB + SEQ + (t1 - nlt) * 64;
            kpre = *(const uint4*)(kr + (size_t)(krow1 + sr_) * 128 + kh * 64 + sch_); vpre = *(const uint4*)(vT + (size_t)(kh * 64 + sr_) * MROWS + krow1 + sch_); }
        __syncthreads();
        f32x4 st[4][2];
#pragma unroll
        for (int i = 0; i < 4; ++i)
#pragma unroll
            for (int j = 0; j < 2; ++j) st[i][j] = (f32x4){0.f, 0.f, 0.f, 0.f};
#pragma unroll
        for (int ks = 0; ks < 2; ++ks) {
#pragma unroll
            for (int kt = 0; kt < 4; ++kt) {
                const bf16x8 kf = *(const bf16x8*)(Ks + (kt * 16 + fr) * 72 + ks * 32 + fq * 8);
#pragma unroll
                for (int qt = 0; qt < 2; ++qt) st[kt][qt] = mfma16(kf, qf[qt][ks], st[kt][qt]);
            }
        }
        if (isloc) {
            const int qpb = nloc * 128 + qq * 32 + fr;
#pragma unroll
            for (int kt = 0; kt < 4; ++kt)
#pragma unroll
                for (int qt = 0; qt < 2; ++qt)
#pragma unroll
                    for (int j = 0; j < 4; ++j) { const int dlt = (qpb + qt * 16) - (kpos0 + kt * 16 + fq * 4 + j); if (dlt > 128 || dlt < -128) st[kt][qt][j] = -1e30f; }
        }
#pragma unroll
        for (int qt = 0; qt < 2; ++qt) {
            float mx = -3e38f;
#pragma unroll
            for (int kt = 0; kt < 4; ++kt)
#pragma unroll
                for (int j = 0; j < 4; ++j) mx = fmaxf(mx, st[kt][qt][j]);
            mx = fmaxf(mx, __shfl_xor(mx, 16)); mx = fmaxf(mx, __shfl_xor(mx, 32));
            const float mn = fmaxf(m[qt], mx); const float alpha = __expf(m[qt] - mn); m[qt] = mn;
            float sum = 0.f;
#pragma unroll
            for (int kt = 0; kt < 4; ++kt)
#pragma unroll
                for (int j = 0; j < 4; ++j) { const float sv = st[kt][qt][j]; const float pv = sv < -1e29f ? 0.f : __expf(sv - mn); st[kt][qt][j] = pv; sum += pv; }
            sum += __shfl_xor(sum, 16); sum += __shfl_xor(sum, 32);
            l[qt] = l[qt] * alpha + sum;
#pragma unroll
            for (int j = 0; j < 4; ++j) { const float al = __shfl(alpha, fq * 4 + j);
#pragma unroll
                for (int dt = 0; dt < 4; ++dt) o[qt][dt][j] *= al; }
        }
#pragma unroll
        for (int ks = 0; ks < 2; ++ks) {
            bf16x8 pf[2];
#pragma unroll
            for (int qt = 0; qt < 2; ++qt) {
                uint4 u4; u4.x = pk2(st[2 * ks][qt][0], st[2 * ks][qt][1]); u4.y = pk2(st[2 * ks][qt][2], st[2 * ks][qt][3]);
                u4.z = pk2(st[2 * ks + 1][qt][0], st[2 * ks + 1][qt][1]); u4.w = pk2(st[2 * ks + 1][qt][2], st[2 * ks + 1][qt][3]);
                pf[qt] = __builtin_bit_cast(bf16x8, u4);
            }
#pragma unroll
            for (int dt = 0; dt < 4; ++dt) {
                const uint2 lo = *(const uint2*)(Vs + (dt * 16 + fr) * 72 + ks * 32 + fq * 4);
                const uint2 hi = *(const uint2*)(Vs + (dt * 16 + fr) * 72 + ks * 32 + 16 + fq * 4);
                const bf16x8 vf = __builtin_bit_cast(bf16x8, make_uint4(lo.x, lo.y, hi.x, hi.y));
#pragma unroll
                for (int qt = 0; qt < 2; ++qt) o[qt][dt] = mfma16(pf[qt], vf, o[qt][dt]);
            }
        }
    }
#pragma unroll
    for (int qt = 0; qt < 2; ++qt) {
        const float il = 1.f / l[qt];
#pragma unroll
        for (int j = 0; j < 4; ++j) {
            const float s = __shfl(il, fq * 4 + j);
            bf16_t* dst = ao + (size_t)(myq0 + qt * 16 + fq * 4 + j) * 1024 + 512 + h * 64 + fr;
#pragma unroll
            for (int dt = 0; dt < 4; ++dt) dst[dt * 16] = f2bf(o[qt][dt][j] * s);
        }
    }
}


#define XB_TMO      128
#define XB_XCNT(j)  (256  + 64 * (j))
#define XB_XSUB(j)  (1280 + 64 * (j))
#define XB_XGEN(j)  (2304 + 64 * (j))
#define XB_TOP      3328
#define XB_TOPGEN   3392
#define XCD_BAR_WORDS 3456
#define XB_SPIN_CAP (1u << 20)
#define LAS __attribute__((address_space(3)))
__device__ __forceinline__ unsigned xb_ld(unsigned* p)              { return __hip_atomic_load(p, __ATOMIC_RELAXED, __HIP_MEMORY_SCOPE_AGENT); }
__device__ __forceinline__ unsigned xb_add(unsigned* p, unsigned v) { return __hip_atomic_fetch_add(p, v, __ATOMIC_RELAXED, __HIP_MEMORY_SCOPE_AGENT); }
__device__ __forceinline__ unsigned xb_xcc_id() { return (unsigned)__builtin_amdgcn_s_getreg((3 << 11) | 20) & 0xFu; }
#define XB_SPIN(cond, bar) do { unsigned _sp = 0; while (cond) { __builtin_amdgcn_s_sleep(1); \
    if ((++_sp & 255u) == 0u) { if (xb_ld(&(bar)[XB_TMO])) break; if (_sp > XB_SPIN_CAP) { atomicAdd(&(bar)[XB_TMO], 1u); break; } } } } while (0)
struct XcdBarrier { unsigned* bar; unsigned x; volatile LAS unsigned* st; };
__device__ __forceinline__ XcdBarrier xcd_barrier_post(unsigned* bar, volatile LAS unsigned* st) {
    XcdBarrier b; b.bar = bar; b.x = xb_xcc_id(); b.st = st;
    if (threadIdx.x == 0) (void)xb_add(&bar[XB_XCNT(b.x)], 1u);
    return b;
}
__device__ __forceinline__ void xcd_barrier_complete(unsigned* bar, unsigned x, unsigned& nloc, unsigned& nx) {
    const unsigned G = gridDim.x * gridDim.y * gridDim.z;
    unsigned sum, cnt, mine, sp = 0u;
    for (;;) {
        sum = 0u; cnt = 0u; mine = 0u;
#pragma unroll
        for (unsigned j = 0; j < 16; ++j) { const unsigned c = xb_ld(&bar[XB_XCNT(j)]); sum += c; cnt += (c > 0u) ? 1u : 0u; mine = (j == x) ? c : mine; }
        if (sum == G) break;
        __builtin_amdgcn_s_sleep(1);
        if ((++sp & 255u) == 0u) { if (xb_ld(&bar[XB_TMO])) break; if (sp > XB_SPIN_CAP) { atomicAdd(&bar[XB_TMO], 1u); break; } }
    }
    nloc = mine > 0u ? mine : 1u; nx = cnt > 0u ? cnt : 1u;
}
__device__ __forceinline__ void xcd_barrier(const XcdBarrier& b) {
    asm volatile("s_waitcnt vmcnt(0)" ::: "memory");
    __syncthreads();
    if (threadIdx.x == 0) {
        unsigned* bar = b.bar;
        __builtin_amdgcn_s_waitcnt(0);
        unsigned nloc = b.st[0], nx = b.st[1];
        if (nloc == 0u) { xcd_barrier_complete(bar, b.x, nloc, nx); b.st[0] = nloc; b.st[1] = nx; }
        const unsigned old = xb_add(&bar[XB_XSUB(b.x)], 1u);
        const unsigned gen = old / nloc;
        if (old + 1u == (gen + 1u) * nloc) {
            __builtin_amdgcn_fence(__ATOMIC_RELEASE, "agent");
            asm volatile("s_waitcnt vmcnt(0)" ::: "memory");
            const unsigned og = xb_add(&bar[XB_TOP], 1u);
            const unsigned tg = og / nx;
            if (og + 1u == (tg + 1u) * nx) xb_add(&bar[XB_TOPGEN], 1u);
            else XB_SPIN(xb_ld(&bar[XB_TOPGEN]) == tg, bar);
            __builtin_amdgcn_fence(__ATOMIC_ACQUIRE, "agent");
            xb_add(&bar[XB_XGEN(b.x)], 1u);
            asm volatile("s_waitcnt vmcnt(0)" ::: "memory");
        } else {
            XB_SPIN(xb_ld(&bar[XB_XGEN(b.x)]) == gen, bar);
            __builtin_amdgcn_fence(__ATOMIC_ACQUIRE, "agent");
            asm volatile("s_waitcnt vmcnt(0)" ::: "memory");
        }
    }
    __syncthreads();
}

__global__ void __launch_bounds__(NT) fwd_megakernel(Params p) {
    extern __shared__ __attribute__((aligned(16))) unsigned char smem[];
    cg::grid_group grid = cg::this_grid();
    __shared__ uint4 xb_words;
    if (threadIdx.x == 0) xb_words = make_uint4(0u, 0u, 0u, 0u);
    __syncthreads();
    const XcdBarrier xb = xcd_barrier_post((unsigned*)(p.ws + OFF_BAR), (volatile LAS unsigned*)&xb_words);
    const int tid = threadIdx.x, lane = tid & 63, wv = tid >> 6;
    const int nb = gridDim.x, bid = blockIdx.x;
    unsigned char* ws = p.ws;
    float* mod = (float*)(ws + OFF_MOD);
    float2* tw = (float2*)(ws + OFF_TW);
    float* xc = (float*)(ws + OFF_XC);
    bf16_t* Wt = (bf16_t*)(ws + OFF_WT);
    bf16_t* hA = (bf16_t*)(ws + OFF_HA);
    float* hT = (float*)(ws + OFF_HT); float* hTc = (float*)(ws + OFF_HTC); float* pn = (float*)(ws + OFF_PN);
    float2* Hf = (float2*)(ws + OFF_HF);
    bf16_t* ubuf = (bf16_t*)(ws + OFF_U);
    bf16_t* gT = (bf16_t*)(ws + OFF_GT); bf16_t* ao = (bf16_t*)(ws + OFF_AO); bf16_t* hid = (bf16_t*)(ws + OFF_HID);
    float* zT = (float*)((unsigned char*)p.out + DO_ZT); bf16_t* x0T = (bf16_t*)((unsigned char*)p.out + DO_X0T);

    {
        int tid = threadIdx.x; asm volatile("" : "+v"(tid)); const int lane = tid & 63, wv = tid >> 6; (void)lane; (void)wv;
        const int nW = 576 + 256 + 1024 + 1024;
        const int nU = nW + 192 + 16 + 256 + 8;
        for (int u = bid; u < nU; u += nb) {
            if (u < 576) convert_w(p.ev_w_in, Wt + W0_IN, 1024, 2304, u, false, smem);
            else if (u < 832) convert_w(p.ev_w_out, Wt + W0_OUT, 1024, 1024, u - 576, false, smem);
            else if (u < 1856) convert_w(p.mlp_w1, Wt + W0_1, 1024, 4096, u - 832, false, smem);
            else if (u < 2880) convert_w(p.mlp_w2, Wt + W0_2, 4096, 1024, u - 1856, false, smem);
            else if (u < nW + 192) mod_unit(p, u - nW, smem);
            else if (u < nW + 208) { const int k = (u - nW - 192) * 512 + tid; float s, c; sincospif((float)k / 8192.f, &s, &c); tw[k] = make_float2(c, -s); }
            else if (u < nW + 208 + 256) { const int fu = u - nW - 208; filter_unit(p, 8192, fu * 32, hT, pn + fu * 1024, smem); }
            else { const int fu = u - nW - 208 - 256; filter_unit(p, 256, fu * 32, hTc, pn + (256 + fu) * 1024, smem); }
        }
    }
    grid.sync();
    {
        int tid = threadIdx.x; asm volatile("" : "+v"(tid)); const int lane = tid & 63, wv = tid >> 6; (void)lane; (void)wv;
        const int nNorm = 0;
        { RowMap rm{p.x, p.ctx, 0, 0}; normmod_phase(MROWS, rm, p.norm_mix_g, mod, 0, 1024, hA, bid * 8 + wv, nb * 8, lane); }
        for (int u = bid; u < 256; u += nb) {
            {
                int tid = threadIdx.x; asm volatile("" : "+v"(tid)); const int lane = tid & 63, wv = tid >> 6;
                const int cA = u, cB = u + 256; float2* X = (float2*)smem; float* red = (float*)(smem + 131072);
                __syncthreads();
                float pa = 0.f, pb = 0.f;
                if (tid < 256) { pa = pn[tid * 1024 + cA] + pn[tid * 1024 + 512 + cA]; pb = pn[tid * 1024 + cB] + pn[tid * 1024 + 512 + cB]; }
#pragma unroll
                for (int o = 32; o >= 1; o >>= 1) { pa += __shfl_xor(pa, o); pb += __shfl_xor(pb, o); }
                if (lane == 0) { red[wv] = pa; red[8 + wv] = pb; }
                __syncthreads();
                float ta = 0.f, tb = 0.f; for (int i = 0; i < 8; ++i) { ta += red[i]; tb += red[8 + i]; }
                const float sa = 1.f / (sqrtf(ta) * 16384.f), sb = 1.f / (sqrtf(tb) * 16384.f);
                const float* a0 = hT + (size_t)cA * 8192; const float* a1 = hT + (size_t)(512 + cA) * 8192;
                const float* b0 = hT + (size_t)cB * 8192; const float* b1 = hT + (size_t)(512 + cB) * 8192;
#pragma unroll 1
                for (int m0 = tid; m0 < 8192; m0 += NT * 8) {
                    float pa_[8], pb_[8], na_[8], nb_[8];
#pragma unroll
                    for (int k = 0; k < 8; ++k) { const int m = m0 + k * NT; pa_[k] = a0[m]; pb_[k] = b0[m]; na_[k] = a1[m]; nb_[k] = b1[m]; }
#pragma unroll
                    for (int k = 0; k < 8; ++k) { const int m = m0 + k * NT; X[m] = make_float2(pa_[k] * sa, pb_[k] * sb); if (m > 0) X[16384 - m] = make_float2(na_[k] * sa, nb_[k] * sb); }
                }
                if (tid == 0) X[8192] = make_float2(0.f, 0.f);
                __syncthreads();
                fft_fwd(X, tw, tid);
                float2* dA = Hf + (size_t)cA * 16384; float2* dB = Hf + (size_t)cB * 16384;
                for (int mI = tid; mI < 16384; mI += NT) {
                    const int k = (int)(__brev((unsigned)mI) >> 18); const int m2 = (int)(__brev((unsigned)((16384 - k) & 16383)) >> 18);
                    const float2 x1 = X[mI], x2 = X[m2];
                    dA[mI] = make_float2(0.5f * (x1.x + x2.x), 0.5f * (x1.y - x2.y));
                    dB[mI] = make_float2(0.5f * (x1.y + x2.y), -0.5f * (x1.x - x2.x));
                }
            }
        }
    }
    xcd_barrier(xb);
    { EpiWin e{ubuf, (bf16_t*)(ws + OFF_QR), (bf16_t*)(ws + OFF_KR), (bf16_t*)(ws + OFF_VT)}; gemm_phase(hA, D, Wt + W0_IN, 1024, MROWS, 2304, 1024, e, smem); }
    xcd_barrier(xb);
    {
        int tid = threadIdx.x; asm volatile("" : "+v"(tid)); const int lane = tid & 63, wv = tid >> 6; (void)lane; (void)wv;
        float* zs = (float*)smem; float* xs = zs + 512 * 33;
        for (int u = bid; u < MROWS / 32; u += nb) {
            const int r0 = u * 32; const int i0 = r0 % RB; const int segEnd = (i0 < SEQ) ? SEQ : RB; const int segBeg = (i0 < SEQ) ? 0 : SEQ;
            const int c = tid;
            float w[3][3], bb[3];
#pragma unroll
            for (int gI = 0; gI < 3; ++gI) { bb[gI] = p.hy_conv_b[gI * 512 + c];
#pragma unroll
                for (int k = 0; k < 3; ++k) w[gI][k] = p.hy_conv_w[k * 1536 + gI * 512 + c]; }
            float prev[3], cur[3], nxt[3];
#pragma unroll
            for (int gI = 0; gI < 3; ++gI) { prev[gI] = (i0 > segBeg) ? bf2f(ubuf[(size_t)(r0 - 1) * 1536 + gI * 512 + c]) : 0.f; cur[gI] = bf2f(ubuf[(size_t)r0 * 1536 + gI * 512 + c]); }
            __syncthreads();
#pragma unroll 1
            for (int tb = 0; tb < 32; tb += 8) {
                bf16_t nx[8][3];
                const int lastr = segEnd - 1 - i0 + r0;
#pragma unroll
                for (int k = 0; k < 8; ++k) { int rr = r0 + tb + k + 1; rr = rr > lastr ? lastr : rr;
#pragma unroll
                    for (int gI = 0; gI < 3; ++gI) nx[k][gI] = ubuf[(size_t)rr * 1536 + gI * 512 + c]; }
#pragma unroll
                for (int k = 0; k < 8; ++k) {
                    const int t = tb + k; const bool hasn = (i0 + t + 1) < segEnd;
                    float cv[3];
#pragma unroll
                    for (int gI = 0; gI < 3; ++gI) { nxt[gI] = hasn ? bf2f(nx[k][gI]) : 0.f; cv[gI] = prev[gI] * w[gI][0] + cur[gI] * w[gI][1] + nxt[gI] * w[gI][2] + bb[gI]; prev[gI] = cur[gI]; cur[gI] = nxt[gI]; }
                    zs[c * 33 + t] = cv[2] * cv[1]; xs[c * 33 + t] = cv[0];
                }
            }
            __syncthreads();
            for (int i = tid; i < 512 * 8; i += NT) {
                const int cc = i >> 3, t4 = (i & 7) * 4;
                *(float4*)(zT + (size_t)cc * MROWS + r0 + t4) = make_float4(zs[cc * 33 + t4], zs[cc * 33 + t4 + 1], zs[cc * 33 + t4 + 2], zs[cc * 33 + t4 + 3]);
                uint2 o; o.x = pk2(xs[cc * 33 + t4], xs[cc * 33 + t4 + 1]); o.y = pk2(xs[cc * 33 + t4 + 2], xs[cc * 33 + t4 + 3]);
                *(uint2*)(x0T + (size_t)cc * MROWS + r0 + t4) = o;
            }
        }
    }
    xcd_barrier(xb);
    {
        int tid = threadIdx.x; asm volatile("" : "+v"(tid)); const int lane = tid & 63, wv = tid >> 6; (void)lane; (void)wv;
        for (int u = bid; u < 512 + 512 + 16 + 512; u += nb) {
            if (u < 512) {
                int tid = threadIdx.x; asm volatile("" : "+v"(tid));
                const int c = u; float2* X = (float2*)smem;
                const float* z0 = zT + (size_t)c * MROWS; const float* z1 = z0 + RB;
                __syncthreads();
#pragma unroll 1
                for (int m0 = tid; m0 < 8192; m0 += NT * 8) {
                    float ra[8], rb[8];
#pragma unroll
                    for (int k = 0; k < 8; ++k) { ra[k] = z0[m0 + k * NT]; rb[k] = z1[m0 + k * NT]; }
#pragma unroll
                    for (int k = 0; k < 8; ++k) { X[m0 + k * NT] = make_float2(ra[k], rb[k]); X[8192 + m0 + k * NT] = make_float2(0.f, 0.f); }
                }
                __syncthreads();
                fft_fwd(X, tw, tid);
                const float2* hf = Hf + (size_t)c * 16384;
#pragma unroll 1
                for (int m0 = tid; m0 < 16384; m0 += NT * 8) {
                    float2 hv[8];
#pragma unroll
                    for (int k = 0; k < 8; ++k) hv[k] = hf[m0 + k * NT];
#pragma unroll
                    for (int k = 0; k < 8; ++k) X[m0 + k * NT] = cmul(X[m0 + k * NT], hv[k]);
                }
                __syncthreads();
                fft_inv(X, tw, tid);
                const float bias = p.hy_bias[c];
                const bf16_t* xa = x0T + (size_t)c * MROWS; bf16_t* g0 = gT + (size_t)c * MROWS;
#pragma unroll 1
                for (int t0 = tid; t0 < 8192; t0 += NT * 4) {
                    bf16_t xa0[4], xa1[4]; float za[4], zb[4];
#pragma unroll
                    for (int k = 0; k < 4; ++k) { const int t = t0 + k * NT; xa0[k] = xa[t]; xa1[k] = xa[RB + t]; za[k] = z0[t]; zb[k] = z1[t]; }
#pragma unroll
                    for (int k = 0; k < 4; ++k) { const int t = t0 + k * NT; const float2 y = X[t];
                        g0[t] = f2bf(bf2f(xa0[k]) * (y.x + za[k] * bias)); g0[RB + t] = f2bf(bf2f(xa1[k]) * (y.y + zb[k] * bias)); }
                }
            } else if (u < 1024) {
                const int uu = u - 512; const int half = uu & 1, kh = (uu >> 1) & 1, n = (uu >> 2) & 63, b = uu >> 8;
                attn_unit(p, b, kh, half, b * RB + n * 128, n, smem);
            } else if (u < 1040) {
                const int uu = u - 1024; const int half = uu & 1, kh = (uu >> 1) & 1, qb = (uu >> 2) & 1, b = uu >> 3;
                attn_unit(p, b, kh, half, b * RB + SEQ + qb * 128, -1, smem);
            } else {
                int tid = threadIdx.x; asm volatile("" : "+v"(tid)); const int lane = tid & 63, wv = tid >> 6;
                const int c = u - 1040; float* hs = (float*)smem; float* zs = hs + 512; float* red = zs + 512;
                __syncthreads();
                float v = 0.f;
                { const int lag = tid - 255; if (tid < 511) v = lag >= 0 ? hTc[(size_t)c * 256 + lag] : hTc[(size_t)(512 + c) * 256 - lag]; }
                hs[tid] = v; float ss = v * v;
                { const int b = tid >> 8, s = tid & 255; zs[tid] = zT[(size_t)c * MROWS + b * RB + SEQ + s]; }
#pragma unroll
                for (int o = 32; o >= 1; o >>= 1) ss += __shfl_xor(ss, o);
                if (lane == 0) red[wv] = ss;
                __syncthreads();
                float tot = 0.f; for (int i = 0; i < 8; ++i) tot += red[i];
                const float inv = 1.f / sqrtf(tot);
                const int b = tid >> 8, t = tid & 255; float a = 0.f;
                for (int s = 0; s < 256; ++s) a += hs[t - s + 255] * zs[b * 256 + s];
                const size_t idx = (size_t)c * MROWS + b * RB + SEQ + t;
                gT[idx] = f2bf(bf2f(x0T[idx]) * (a * inv + zs[tid] * p.hy_bias[c]));
            }
        }
    }
    xcd_barrier(xb);
    {
        int tid = threadIdx.x; asm volatile("" : "+v"(tid)); const int lane = tid & 63, wv = tid >> 6; (void)lane; (void)wv;
        bf16_t* ts = (bf16_t*)smem;
        for (int u = bid; u < 8 * (MROWS / 64); u += nb) {
            const int cb = u & 7, rb = u >> 3;
            __syncthreads();
            { const int c = tid >> 3, r8 = (tid & 7) * 8; const uint4 v = *(const uint4*)(gT + (size_t)(cb * 64 + c) * MROWS + rb * 64 + r8);
#pragma unroll
              for (int i = 0; i < 8; ++i) ts[c * 66 + r8 + i] = u4e(v, i); }
            __syncthreads();
            { const int r = tid >> 3, c8 = (tid & 7) * 8; uint4 o;
              o.x = (unsigned)ts[(c8 + 0) * 66 + r] | ((unsigned)ts[(c8 + 1) * 66 + r] << 16); o.y = (unsigned)ts[(c8 + 2) * 66 + r] | ((unsigned)ts[(c8 + 3) * 66 + r] << 16);
              o.z = (unsigned)ts[(c8 + 4) * 66 + r] | ((unsigned)ts[(c8 + 5) * 66 + r] << 16); o.w = (unsigned)ts[(c8 + 6) * 66 + r] | ((unsigned)ts[(c8 + 7) * 66 + r] << 16);
              *(uint4*)(ao + (size_t)(rb * 64 + r) * 1024 + cb * 64 + c8) = o; }
        }
    }
    xcd_barrier(xb);
    { EpiRes0 e{p.x, p.ctx, p.out, xc, mod, 2048}; gemm_phase(ao, 1024, Wt + W0_OUT, 1024, MROWS, 1024, 1024, e, smem); }
    xcd_barrier(xb);
    {
        int tid = threadIdx.x; asm volatile("" : "+v"(tid)); const int lane = tid & 63, wv = tid >> 6; (void)lane; (void)wv;
    { RowMap rm{p.out, xc, 0, 0}; normmod_phase(MROWS, rm, p.norm_mlp_g, mod, 3072, 4096, hA, bid * 8 + wv, nb * 8, lane); }
    }
    xcd_barrier(xb);
    { EpiRelu2 e{hid, 4096}; gemm_phase(hA, D, Wt + W0_1, 1024, MROWS, 4096, 1024, e, smem); }
    xcd_barrier(xb);
    { EpiRes0 e{p.out, xc, p.out, xc, mod, 5120}; gemm_phase<true>(hid, 4096, Wt + W0_2, 4096, MROWS, 1024, 4096, e, smem); }
    xcd_barrier(xb);
    const float* mod1 = mod + 3 * 6144;
    for (int u = bid; u < 2048 + 512 + 1024 + 1024; u += nb) {
        if (u < 2048) convert_w(p.od_w_in, Wt + W1_IN, 1024, 8192, u, true, smem);
        else if (u < 2560) convert_w(p.od_w_out, Wt + W1_OUT, 2048, 1024, u - 2048, false, smem);
        else if (u < 3584) convert_w(p.mlp_w1 + (size_t)1024 * 4096, Wt + W1_1, 1024, 4096, u - 2560, false, smem);
        else convert_w(p.mlp_w2 + (size_t)4096 * 1024, Wt + W1_2, 4096, 1024, u - 3584, false, smem);
    }
    bf16_t* q1 = (bf16_t*)(ws + OFF_Q1); bf16_t* kz = (bf16_t*)(ws + OFF_KZ); bf16_t* v1 = (bf16_t*)(ws + OFF_V1);
    bf16_t* inn = (bf16_t*)(ws + OFF_IN); bf16_t* sg = (bf16_t*)(ws + OFF_SG); float* ps = (float*)(ws + OFF_PS);
#pragma unroll 1
    for (int b = 0; b < 2; ++b) {
        int tid = threadIdx.x; asm volatile("" : "+v"(tid));
        const int lane = tid & 63, wv = tid >> 6;
        { RowMap rm{p.out, xc, 1, b}; normmod_phase(RB, rm, p.norm_mix_g + 1024, mod1, 0, 1024, hA, bid * 8 + wv, nb * 8, lane); }
        xcd_barrier(xb);
        { EpiRet e{q1, kz, v1, sg, p.ret_log_rate}; gemm_phase(hA, D, Wt + W1_IN, 1024, RB, 8192, 1024, e, smem); }
        xcd_barrier(xb);
        {
            bf16_t* Ks = (bf16_t*)smem;
            const int fr = lane & 15, fq = lane >> 4;
            for (int u = bid; u < 512; u += nb) {
                const int n = u & 63, h = (u >> 6) & 3, dir = u >> 8;
                const float lg = -__expf(p.ret_log_rate[dir * 4 + h]);
                __syncthreads();
                for (int i = tid; i < 256 * 16; i += NT) {
                    const int dk = i >> 4, t8 = (i & 15) * 8;
                    const uint4 v = *(const uint4*)(kz + ((size_t)dir * 1024 + h * 256 + dk) * RB + n * 128 + t8);
#pragma unroll
                    for (int k = 0; k < 8; ++k) Ks[(t8 + k) * 264 + dk] = u4e(v, k);
                }
                __syncthreads();
                f32x4 acc[8];
#pragma unroll
                for (int i = 0; i < 8; ++i) acc[i] = (f32x4){0.f, 0.f, 0.f, 0.f};
                const bf16_t* qp = q1 + ((size_t)dir * SEQ + n * 128 + wv * 16 + fr) * 1024 + h * 256 + fq * 8;
#pragma unroll
                for (int ks = 0; ks < 8; ++ks) {
                    const bf16x8 af = *(const bf16x8*)(qp + ks * 32);
#pragma unroll
                    for (int nt = 0; nt < 8; ++nt) { const bf16x8 bfv = *(const bf16x8*)(Ks + (nt * 16 + fr) * 264 + ks * 32 + fq * 8); acc[nt] = mfma16(af, bfv, acc[nt]); }
                }
                bf16_t* dst = inn + ((size_t)(dir * 4 + h) * 64 + n) * 16384;
#pragma unroll
                for (int j = 0; j < 4; ++j) {
                    const int a = wv * 16 + fq * 4 + j;
                    const float fac = dir == 0 ? __expf((float)(a - 127) * lg) : __expf(-(float)a * lg);
#pragma unroll
                    for (int nt = 0; nt < 8; ++nt) { const int ap = nt * 16 + fr; const bool ok = dir == 0 ? (a >= ap) : (ap >= a); dst[a * 128 + ap] = f2bf(ok ? acc[nt][j] * fac : 0.f); }
                }
            }
        }
        xcd_barrier(xb);
        {
            bf16_t* Wq = (bf16_t*)(smem + wv * 8192);
            bf16_t* Wi = (bf16_t*)(smem + 65536 + wv * 4096);
            bf16_t* Wg = (bf16_t*)(smem + 98304 + wv * 512);
            bf16_t* Vs = (bf16_t*)(smem + 102400);
            bf16_t* Rl = (bf16_t*)(smem + 110592);
            const int fr = lane & 15, fq = lane >> 4;
            for (int wk0 = bid; wk0 < 256; wk0 += nb) {
                const int wk = (wk0 & 7) * 32 + (wk0 >> 3);
                const int sl = wk & 31, h = (wk >> 5) & 3, dir = wk >> 7;
                const float lg = -__expf(p.ret_log_rate[dir * 4 + h]); const float gC = __expf(128.f * lg);
                const int vcol = h * 512 + sl * 16;
                f32x4 racc0 = (f32x4){0.f, 0.f, 0.f, 0.f}, racc1 = racc0;
                const bf16_t* qg_p = q1 + ((size_t)dir * SEQ + wv * 16 + (lane >> 5)) * 1024 + h * 256 + (lane & 31) * 8;
                const bf16_t* kg_p = kz + ((size_t)dir * 1024 + h * 256 + wv * 32 + (lane >> 4)) * RB + (lane & 15) * 8;
                const bf16_t* ig_p = inn + ((size_t)(dir * 4 + h) * 64) * 16384 + (wv * 16 + (lane >> 4)) * 128 + (lane & 15) * 8;
                const bf16_t* vg_p = v1 + (size_t)(vcol + ((tid >> 4) & 15)) * RB + (tid & 15) * 8;
                bf16_t* gg_p = sg + ((size_t)dir * SEQ + wv * 16 + ((lane >> 1) & 15)) * 2048 + vcol + (lane & 1) * 8;
                float* pg_p = ps + (((size_t)dir * SEQ + wv * 16 + fq * 4) * 4 + h) * 32 + sl;
                bf16_t* qs_d = Wq + (lane >> 5) * 256 + (((lane & 31) ^ (lane >> 5)) * 8);
                bf16_t* ks_d = Wq + (lane >> 4) * 128;
                bf16_t* is_d = Wi + (lane >> 4) * 128;
                bf16_t* vs_d = Vs + ((tid >> 4) & 15) * 128 + (((tid & 15) ^ ((tid >> 4) & 15)) * 8);
                bf16_t* gs_d = Wg + ((lane >> 1) & 15) * 16 + (lane & 1) * 8;
                (void)qs_d;
                float xi[4];
#pragma unroll
                for (int j = 0; j < 4; ++j) { const int a = wv * 16 + fq * 4 + j; xi[j] = dir == 0 ? __expf((float)(a + 1) * lg) : __expf((float)(128 - a) * lg); }
#define SC_ROW(st) ((st) < 2 ? SEQ + (dir == 0 ? (st) : 1 - (st)) * 128 : (dir == 0 ? (st) - 2 : 65 - (st)) * 128)
                uint4 qg0, qg1, qg2, qg3, qg4, qg5, qg6, qg7, kg0, kg1, kg2, kg3, kg4, kg5, kg6, kg7, ig0, ig1, ig2, ig3, vg, gg;
                qg0 = qg1 = qg2 = qg3 = qg4 = qg5 = qg6 = qg7 = make_uint4(0, 0, 0, 0); ig0 = ig1 = ig2 = ig3 = qg0; gg = qg0; vg = qg0;
#define SC_LDK(r0) { const bf16_t* kp_ = kg_p + (r0); kg0 = *(const uint4*)(kp_); kg1 = *(const uint4*)(kp_ + (size_t)4 * RB); kg2 = *(const uint4*)(kp_ + (size_t)8 * RB); kg3 = *(const uint4*)(kp_ + (size_t)12 * RB); \
    kg4 = *(const uint4*)(kp_ + (size_t)16 * RB); kg5 = *(const uint4*)(kp_ + (size_t)20 * RB); kg6 = *(const uint4*)(kp_ + (size_t)24 * RB); kg7 = *(const uint4*)(kp_ + (size_t)28 * RB); }
#define SC_LDQ(r0) { const bf16_t* qp_ = qg_p + (size_t)(r0) * 1024; qg0 = *(const uint4*)(qp_); qg1 = *(const uint4*)(qp_ + 2 * 1024); qg2 = *(const uint4*)(qp_ + 4 * 1024); qg3 = *(const uint4*)(qp_ + 6 * 1024); \
    qg4 = *(const uint4*)(qp_ + 8 * 1024); qg5 = *(const uint4*)(qp_ + 10 * 1024); qg6 = *(const uint4*)(qp_ + 12 * 1024); qg7 = *(const uint4*)(qp_ + 14 * 1024); \
    const bf16_t* ip_ = ig_p + (size_t)((r0) >> 7) * 16384; ig0 = *(const uint4*)(ip_); ig1 = *(const uint4*)(ip_ + 4 * 128); ig2 = *(const uint4*)(ip_ + 8 * 128); ig3 = *(const uint4*)(ip_ + 12 * 128); \
    if (lane < 32) gg = *(const uint4*)(gg_p + (size_t)(r0) * 2048); }
#define SC_STQ(i, v) { const int row_ = 2 * (i) + (lane >> 5); *(uint4*)(Wq + row_ * 256 + (((lane & 31) ^ row_) * 8)) = (v); }
#define SC_STK(i, v) { const int row_ = 4 * (i) + (lane >> 4); *(uint4*)(ks_d + 4 * (i) * 128 + (((lane & 15) ^ (row_ & 15)) * 8)) = (v); }
#define SC_STI(i, v) { const int row_ = 4 * (i) + (lane >> 4); *(uint4*)(is_d + 4 * (i) * 128 + (((lane & 15) ^ (row_ & 15)) * 8)) = (v); }
                SC_LDK(SC_ROW(0))
                if (tid < 256) vg = *(const uint4*)(vg_p + SC_ROW(0));
#pragma unroll 1
                for (int st = 0; st < 66; ++st) {
                    const bool lat = st >= 2; const int row0 = SC_ROW(st); const int nrow = SC_ROW(st + 1);
                    const bool hasn = st + 1 < 66; const bool nlat = st + 1 >= 2 && hasn;
                    bf16_t* vsb = Vs + (st & 1) * 2048;
                    if (lat) {
                        SC_STQ(0, qg0) SC_STQ(1, qg1) SC_STQ(2, qg2) SC_STQ(3, qg3) SC_STQ(4, qg4) SC_STQ(5, qg5) SC_STQ(6, qg6) SC_STQ(7, qg7)
                        SC_STI(0, ig0) SC_STI(1, ig1) SC_STI(2, ig2) SC_STI(3, ig3)
                        if (lane < 32) *(uint4*)(gs_d) = gg;
                        bf16_t* rw = Rl + (st & 1) * 16 * 264 + fr * 264 + wv * 32 + fq * 4;
                        uint2 t; t.x = pk2(racc0[0], racc0[1]); t.y = pk2(racc0[2], racc0[3]); *(uint2*)(rw) = t;
                        t.x = pk2(racc1[0], racc1[1]); t.y = pk2(racc1[2], racc1[3]); *(uint2*)(rw + 16) = t;
                    }
                    if (tid < 256) *(uint4*)(vs_d + (st & 1) * 2048) = vg;
                    if (nlat) SC_LDQ(nrow)
                    if (hasn && tid < 256) vg = *(const uint4*)(vg_p + nrow);
                    __syncthreads();
                    const bf16x8 vf0 = *(const bf16x8*)(vsb + fr * 128 + (((0 + fq) ^ fr) * 8)), vf1 = *(const bf16x8*)(vsb + fr * 128 + (((4 + fq) ^ fr) * 8));
                    const bf16x8 vf2 = *(const bf16x8*)(vsb + fr * 128 + (((8 + fq) ^ fr) * 8)), vf3 = *(const bf16x8*)(vsb + fr * 128 + (((12 + fq) ^ fr) * 8));
                    if (lat) {
                        f32x4 oq = (f32x4){0.f, 0.f, 0.f, 0.f}, oq2 = oq, oi = oq;
                        const bf16_t* qrow = Wq + fr * 256; const bf16_t* irow = Wi + fr * 128;
                        const bf16_t* rl = Rl + (st & 1) * 16 * 264 + fr * 264 + fq * 8;
#pragma unroll
                        for (int ks = 0; ks < 8; ks += 2) {
                            oq = mfma16(*(const bf16x8*)(qrow + (((ks * 4 + fq) ^ fr) * 8)), *(const bf16x8*)(rl + ks * 32), oq);
                            oq2 = mfma16(*(const bf16x8*)(qrow + ((((ks + 1) * 4 + fq) ^ fr) * 8)), *(const bf16x8*)(rl + (ks + 1) * 32), oq2);
                        }
                        oi = mfma16(*(const bf16x8*)(irow + (((0 + fq) ^ fr) * 8)), vf0, oi); oi = mfma16(*(const bf16x8*)(irow + (((4 + fq) ^ fr) * 8)), vf1, oi);
                        oi = mfma16(*(const bf16x8*)(irow + (((8 + fq) ^ fr) * 8)), vf2, oi); oi = mfma16(*(const bf16x8*)(irow + (((12 + fq) ^ fr) * 8)), vf3, oi);
                        float ov[4];
#pragma unroll
                        for (int j = 0; j < 4; ++j) ov[j] = oi[j] + xi[j] * (oq[j] + oq2[j]);
                        const float q0_ = row16_sum(ov[0] * ov[0]), q1_ = row16_sum(ov[1] * ov[1]), q2_ = row16_sum(ov[2] * ov[2]), q3_ = row16_sum(ov[3] * ov[3]);
                        if (fr == 0) { float* pp = pg_p + (size_t)row0 * 128; pp[0] = q0_; pp[128] = q1_; pp[256] = q2_; pp[384] = q3_; }
                        bf16_t* gp_ = Wg + (fq * 4) * 16 + fr;
#pragma unroll
                        for (int j = 0; j < 4; ++j) gp_[j * 16] = f2bf(bf2f(gp_[j * 16]) * ov[j]);
                        if (lane < 32) *(uint4*)(gg_p + (size_t)row0 * 2048) = *(const uint4*)(gs_d);
                    }
                    SC_STK(0, kg0) SC_STK(1, kg1) SC_STK(2, kg2) SC_STK(3, kg3) SC_STK(4, kg4) SC_STK(5, kg5) SC_STK(6, kg6) SC_STK(7, kg7)
                    if (hasn) SC_LDK(nrow)
                    racc0 = racc0 * gC; racc1 = racc1 * gC;
                    {
                        const bf16_t* k0 = Wq + fr * 128; const bf16_t* k1 = k0 + 16 * 128;
                        racc0 = mfma16(*(const bf16x8*)(k0 + (((0 + fq) ^ fr) * 8)), vf0, racc0); racc1 = mfma16(*(const bf16x8*)(k1 + (((0 + fq) ^ fr) * 8)), vf0, racc1);
                        racc0 = mfma16(*(const bf16x8*)(k0 + (((4 + fq) ^ fr) * 8)), vf1, racc0); racc1 = mfma16(*(const bf16x8*)(k1 + (((4 + fq) ^ fr) * 8)), vf1, racc1);
                        racc0 = mfma16(*(const bf16x8*)(k0 + (((8 + fq) ^ fr) * 8)), vf2, racc0); racc1 = mfma16(*(const bf16x8*)(k1 + (((8 + fq) ^ fr) * 8)), vf2, racc1);
                        racc0 = mfma16(*(const bf16x8*)(k0 + (((12 + fq) ^ fr) * 8)), vf3, racc0); racc1 = mfma16(*(const bf16x8*)(k1 + (((12 + fq) ^ fr) * 8)), vf3, racc1);
                    }
                }
                __syncthreads();
            }
        }
        xcd_barrier(xb);
        for (int u = bid; u < SEQ / 8; u += nb) {
            const int r = u * 8 + wv;
            float rv[4];
#pragma unroll
            for (int i = 0; i < 4; ++i) {
                const int dir = i >> 1, hh = (i & 1) * 2 + (lane >> 5), s = lane & 31;
                float v = ps[(((size_t)dir * SEQ + r) * 4 + hh) * 32 + s];
                v += __shfl_xor(v, 1); v += __shfl_xor(v, 2); v += __shfl_xor(v, 4); v += __shfl_xor(v, 8); v += __shfl_xor(v, 16);
                rv[i] = rsqrtf(v * (1.f / 512.f) + 1e-6f);
            }
            bf16_t* pf = sg + (size_t)r * 2048 + lane * 4; const bf16_t* pb = pf + (size_t)SEQ * 2048;
            uint2 la[8], lb[8];
#pragma unroll
            for (int it = 0; it < 8; ++it) { la[it] = *(const uint2*)(pf + it * 256); lb[it] = *(const uint2*)(pb + it * 256); }
#pragma unroll
            for (int it = 0; it < 8; ++it) {
                const int hh = it >> 1;
                const float rf = __shfl(rv[hh >> 1], (hh & 1) * 32), rbk = __shfl(rv[2 + (hh >> 1)], (hh & 1) * 32);
                const uint2 a = la[it], bq = lb[it];
                uint2 o; o.x = pk2(bf2f(u2e(a, 0)) * rf + bf2f(u2e(bq, 0)) * rbk, bf2f(u2e(a, 1)) * rf + bf2f(u2e(bq, 1)) * rbk); o.y = pk2(bf2f(u2e(a, 2)) * rf + bf2f(u2e(bq, 2)) * rbk, bf2f(u2e(a, 3)) * rf + bf2f(u2e(bq, 3)) * rbk);
                *(uint2*)(pf + it * 256) = o;
            }
        }
        xcd_barrier(xb);
        { EpiResLat e{p.out, mod1, 2048, b * SEQ}; gemm_phase(sg, 2048, Wt + W1_OUT, 2048, SEQ, 1024, 2048, e, smem); }
        xcd_barrier(xb);
    }
    int tid2 = threadIdx.x; asm volatile("" : "+v"(tid2));
    const int lane2 = tid2 & 63, wv2 = tid2 >> 6;
    { RowMap rm{p.out, xc, 2, 0}; normmod_phase(16384, rm, p.norm_mlp_g + 1024, mod1, 3072, 4096, hA, bid * 8 + wv2, nb * 8, lane2); }
    xcd_barrier(xb);
    { EpiRelu2 e{hid, 4096}; gemm_phase(hA, D, Wt + W1_1, 1024, 16384, 4096, 1024, e, smem); }
    xcd_barrier(xb);
    { EpiResLat e{p.out, mod1, 5120, 0}; gemm_phase(hid, 4096, Wt + W1_2, 4096, 16384, 1024, 4096, e, smem); }
    xcd_barrier(xb);
    for (int u = bid; u < 16384 / 8; u += nb) {
        const int r = u * 8 + wv2; float* row = p.out + (size_t)r * D;
        float4 v[4]; float ss = 0.f;
#pragma unroll
        for (int i = 0; i < 4; ++i) { v[i] = *(const float4*)(row + i * 256 + lane2 * 4); ss += v[i].x * v[i].x + v[i].y * v[i].y + v[i].z * v[i].z + v[i].w * v[i].w; }
#pragma unroll
        for (int o = 32; o >= 1; o >>= 1) ss += __shfl_xor(ss, o);
        const float rsd = rsqrtf(ss * (1.f / 1024.f) + 1e-6f);
#pragma unroll
        for (int i = 0; i < 4; ++i) { const float4 gg = *(const float4*)(p.final_g + i * 256 + lane2 * 4); *(float4*)(row + i * 256 + lane2 * 4) = make_float4(v[i].x * rsd * gg.x, v[i].y * rsd * gg.y, v[i].z * rsd * gg.z, v[i].w * rsd * gg.w); }
    }
}

extern "C" void kernel_launch(void* const* d_in, const int* in_sizes, int n_in, void* d_out, int out_size, void* d_ws, size_t ws_size, hipStream_t stream) {
    static int grid_blocks = 0;
    if (!grid_blocks) {
        int dev = 0, cus = 0, per_cu = 0;
        hipGetDevice(&dev);
        hipDeviceGetAttribute(&cus, hipDeviceAttributeMultiprocessorCount, dev);
        hipFuncSetAttribute((const void*)fwd_megakernel, hipFuncAttributeMaxDynamicSharedMemorySize, LDS_BYTES);
        hipOccupancyMaxActiveBlocksPerMultiprocessor(&per_cu, (const void*)fwd_megakernel, NT, LDS_BYTES);
        if (per_cu < 1) per_cu = 1;
        grid_blocks = (cus * per_cu) & ~7;
        if (ws_size < 256 * MiB) fprintf(stderr, "workspace too small: %zu\n", ws_size);
    }
    Params p{};
    const float** pp = (const float**)&p;
    for (int i = 0; i < 27; ++i) pp[i] = (const float*)d_in[i];
    p.out = (float*)d_out; p.ws = (unsigned char*)d_ws;
    (void)hipMemsetAsync((unsigned char*)d_ws + OFF_BAR, 0, XCD_BAR_WORDS * 4, stream);
    void* args[] = {&p};
    hipError_t e = hipLaunchCooperativeKernel((void*)fwd_megakernel, dim3(grid_blocks), dim3(NT), args, LDS_BYTES, stream);
    if (e != hipSuccess) fprintf(stderr, "cooperative launch failed: %s (grid %d)\n", hipGetErrorString(e), grid_blocks);
}
```

```cpp
#include <hip/hip_runtime.h>
#include <hip/hip_cooperative_groups.h>
#include <cstdio>
#include <cstdint>
namespace cg = cooperative_groups;

typedef unsigned short bf16_t;
typedef short bf16x8 __attribute__((ext_vector_type(8)));
typedef short bf16x4 __attribute__((ext_vector_type(4)));
typedef float f32x4 __attribute__((ext_vector_type(4)));

#define NT 512
constexpr int D = 1024, SEQ = 8192, CTXL = 256, RB = 8448, MROWS = 16896;
constexpr int LDS_BYTES = 139264;
constexpr size_t MiB = 1048576;
constexpr size_t OFF_MOD = 0;
constexpr size_t OFF_BAR = 512 * 1024;
constexpr size_t OFF_TW = 1 * MiB;
constexpr size_t OFF_XC = 2 * MiB;
constexpr size_t OFF_WT = 4 * MiB;
constexpr size_t OFF_HA = 40 * MiB;
constexpr size_t OFF_HT = 73 * MiB;
constexpr size_t OFF_HTC = 105 * MiB;
constexpr size_t OFF_PN = 106 * MiB;
constexpr size_t OFF_HF = 108 * MiB;
constexpr size_t OFF_U = 172 * MiB;
constexpr size_t OFF_QR = 222 * MiB;
constexpr size_t OFF_KR = 239 * MiB;
constexpr size_t OFF_VT = 244 * MiB;
constexpr size_t OFF_GT = 73 * MiB;
constexpr size_t OFF_AO = 172 * MiB;
constexpr size_t OFF_HID = 73 * MiB;
constexpr size_t DO_ZT = 0, DO_X0T = 33 * MiB;
constexpr size_t OFF_Q1 = 57 * MiB;
constexpr size_t OFF_KZ = 89 * MiB;
constexpr size_t OFF_V1 = 122 * MiB;
constexpr size_t OFF_IN = 155 * MiB;
constexpr size_t OFF_SG = 171 * MiB;
constexpr size_t OFF_PS = 235 * MiB;
constexpr size_t W0_IN = 0, W0_OUT = W0_IN + 2304 * 1024, W0_1 = W0_OUT + 1024 * 1024, W0_2 = W0_1 + 4096 * 1024;
constexpr size_t W1_IN = 0, W1_OUT = W1_IN + 8192 * 1024, W1_1 = W1_OUT + 1024 * 2048, W1_2 = W1_1 + 4096 * 1024;

struct Params {
    const float *x, *c, *ctx, *c_ctx, *ada_w, *ada_b, *norm_mix_g, *norm_mlp_g, *mlp_w1, *mlp_w2, *ev_w_in, *ev_w_out, *hy_conv_w, *hy_conv_b,
        *hy_w1, *hy_b1, *hy_w2, *hy_b2, *hy_w3, *hy_freq, *hy_decay, *hy_bias, *attn_sink, *od_w_in, *od_w_out, *ret_log_rate, *final_g;
    float* out; unsigned char* ws;
};

__device__ __forceinline__ bf16_t f2bf(float f) { unsigned u = __float_as_uint(f); u += 0x7fffu + ((u >> 16) & 1u); return (bf16_t)(u >> 16); }
__device__ __forceinline__ float bf2f(bf16_t h) { return __uint_as_float(((unsigned)h) << 16); }
__device__ __forceinline__ unsigned pk2(float a, float b) { return (unsigned)f2bf(a) | ((unsigned)f2bf(b) << 16); }
__device__ __forceinline__ bf16_t u4e(const uint4& v, int i) { const unsigned w = (i >> 1) == 0 ? v.x : (i >> 1) == 1 ? v.y : (i >> 1) == 2 ? v.z : v.w; return (bf16_t)((i & 1) ? (w >> 16) : (w & 0xffffu)); }
__device__ __forceinline__ bf16_t u2e(const uint2& v, int i) { const unsigned w = (i >> 1) == 0 ? v.x : v.y; return (bf16_t)((i & 1) ? (w >> 16) : (w & 0xffffu)); }
#define DPP_ADD(v, ctrl) ((v) + __builtin_bit_cast(float, __builtin_amdgcn_update_dpp(0, __builtin_bit_cast(int, (v)), (ctrl), 0xF, 0xF, true)))
__device__ __forceinline__ float row16_sum(float v) { v = DPP_ADD(v, 0xB1); v = DPP_ADD(v, 0x4E); v = DPP_ADD(v, 0x141); v = DPP_ADD(v, 0x140); return v; }
__device__ __forceinline__ float siluf(float v) { return v * __builtin_amdgcn_rcpf(1.f + __expf(-v)); }
__device__ __forceinline__ void fast_sincos(float x, float& s, float& c) {
    float k = rintf(x * 0.15915494309189535f);
    float r = fmaf(-k, 6.28125f, x); r = fmaf(-k, 1.9353071795864769e-3f, r);
    s = __sinf(r); c = __cosf(r);
}
__device__ __forceinline__ float2 cmul(float2 a, float2 b) { return make_float2(a.x * b.x - a.y * b.y, a.x * b.y + a.y * b.x); }
__device__ __forceinline__ float2 cadd(float2 a, float2 b) { return make_float2(a.x + b.x, a.y + b.y); }
__device__ __forceinline__ float2 csub(float2 a, float2 b) { return make_float2(a.x - b.x, a.y - b.y); }
__device__ __forceinline__ f32x4 mfma16(bf16x8 a, bf16x8 b, f32x4 c) { return __builtin_amdgcn_mfma_f32_16x16x32_bf16(a, b, c, 0, 0, 0); }

template <bool SPLIT = false, class Epi>
__device__ __forceinline__ void gemm_phase(const bf16_t* __restrict__ A, int lda, const bf16_t* __restrict__ Bt, int ldb, int M, int N, int K, const Epi& epi, unsigned char* smem) {
    int tid = threadIdx.x; asm volatile("" : "+v"(tid));
    const int lane = tid & 63, w = tid >> 6, wm = w >> 1, wn = w & 1;
    const int nN = N / 128, ntiles = (M / 256) * nN, nk = K / 64;
    bf16_t* As = (bf16_t*)smem;
    bf16_t* Bs = As + 2 * 256 * 64;
    const int lr = tid >> 3, lc = (tid & 7) * 8;
    const int fr = lane & 15, fq = lane >> 4;
    const int xcd_ = blockIdx.x & 7, jl_ = blockIdx.x >> 3, nbl_ = gridDim.x >> 3;
    const int tbeg_ = (int)(((long)ntiles * xcd_) >> 3), tend_ = (int)(((long)ntiles * (xcd_ + 1)) >> 3);
    const int len_ = tend_ - tbeg_; const int full_ = SPLIT ? (len_ / nbl_) * nbl_ : len_; const int tail_ = len_ - full_;
    int parts_ = 1;
    if (SPLIT && tail_ > 0) { const int lim = (nbl_ / tail_) < (nk >> 1) ? (nbl_ / tail_) : (nk >> 1); while (parts_ * 2 <= lim) parts_ *= 2; }
#define G_ITEM(IT, TILE, KB, NKK, ATOM, OK) { OK = true; KB = 0; NKK = nk; ATOM = false; TILE = 0; \
        if ((IT) < full_) TILE = tbeg_ + (IT); \
        else if (SPLIT && parts_ > 1 && (IT) - full_ < tail_ * parts_) { const int e_ = (IT) - full_; TILE = tbeg_ + full_ + e_ / parts_; NKK = nk / parts_; KB = (e_ % parts_) * NKK; ATOM = true; } \
        else if ((IT) < len_ && parts_ == 1) TILE = tbeg_ + (IT); \
        else OK = false; }
    uint4 pa0, pa1, pa2, pa3, pb0, pb1;
    uint4 qa0, qa1, qa2, qa3, qb0, qb1;
    bool primed_ = false;
    for (int it = jl_; ; it += nbl_) {
        int tile, kb_, nkk; bool atom_, ok_;
        G_ITEM(it, tile, kb_, nkk, atom_, ok_)
        if (!ok_) break;
        const int tm = tile / nN, tn = tile % nN;
        const bf16_t* Ag = A + (size_t)(tm * 256 + lr) * lda + lc + kb_ * 64;
        const bf16_t* Bg = Bt + (size_t)(tn * 128 + lr) * ldb + lc + kb_ * 64;
        int ntile_, nkb_, nnkk_; bool natom_, nok_;
        G_ITEM(it + nbl_, ntile_, nkb_, nnkk_, natom_, nok_)
        (void)natom_; (void)nnkk_;
        const bf16_t* Agn = A + (size_t)((ntile_ / nN) * 256 + lr) * lda + lc + nkb_ * 64;
        const bf16_t* Bgn = Bt + (size_t)((ntile_ % nN) * 128 + lr) * ldb + lc + nkb_ * 64;
        f32x4 acc[4][4];
#pragma unroll
        for (int i = 0; i < 4; ++i)
#pragma unroll
            for (int j = 0; j < 4; ++j) acc[i][j] = (f32x4){0.f, 0.f, 0.f, 0.f};
#define G_LOADN(P, kt_) { const bf16_t* ag = Agn + (kt_) * 64; const bf16_t* bg = Bgn + (kt_) * 64; \
    P##a0 = *(const uint4*)(ag); P##a1 = *(const uint4*)(ag + (size_t)64 * lda); P##a2 = *(const uint4*)(ag + (size_t)128 * lda); P##a3 = *(const uint4*)(ag + (size_t)192 * lda); \
    P##b0 = *(const uint4*)(bg); P##b1 = *(const uint4*)(bg + (size_t)64 * ldb); }
#define G_LOAD(P, kt_) { const bf16_t* ag = Ag + (kt_) * 64; const bf16_t* bg = Bg + (kt_) * 64; \
    P##a0 = *(const uint4*)(ag); P##a1 = *(const uint4*)(ag + (size_t)64 * lda); P##a2 = *(const uint4*)(ag + (size_t)128 * lda); P##a3 = *(const uint4*)(ag + (size_t)192 * lda); \
    P##b0 = *(const uint4*)(bg); P##b1 = *(const uint4*)(bg + (size_t)64 * ldb); }
#define G_STORE(P, buf_) { const int lcs = ((tid & 7) ^ ((tid >> 4) & 7)) * 8; bf16_t* ad = As + (buf_) * 256 * 64 + lr * 64 + lcs; bf16_t* bd = Bs + (buf_) * 128 * 64 + lr * 64 + lcs; \
    *(uint4*)(ad) = P##a0; *(uint4*)(ad + 64 * 64) = P##a1; *(uint4*)(ad + 128 * 64) = P##a2; *(uint4*)(ad + 192 * 64) = P##a3; \
    *(uint4*)(bd) = P##b0; *(uint4*)(bd + 64 * 64) = P##b1; }
#define G_MFMA16(a0, a1, a2, a3, b0, b1, b2, b3) { __builtin_amdgcn_s_setprio(1); \
        acc[0][0] = mfma16(a0, b0, acc[0][0]); acc[0][1] = mfma16(a0, b1, acc[0][1]); acc[0][2] = mfma16(a0, b2, acc[0][2]); acc[0][3] = mfma16(a0, b3, acc[0][3]); \
        acc[1][0] = mfma16(a1, b0, acc[1][0]); acc[1][1] = mfma16(a1, b1, acc[1][1]); acc[1][2] = mfma16(a1, b2, acc[1][2]); acc[1][3] = mfma16(a1, b3, acc[1][3]); \
        acc[2][0] = mfma16(a2, b0, acc[2][0]); acc[2][1] = mfma16(a2, b1, acc[2][1]); acc[2][2] = mfma16(a2, b2, acc[2][2]); acc[2][3] = mfma16(a2, b3, acc[2][3]); \
        acc[3][0] = mfma16(a3, b0, acc[3][0]); acc[3][1] = mfma16(a3, b1, acc[3][1]); acc[3][2] = mfma16(a3, b2, acc[3][2]); acc[3][3] = mfma16(a3, b3, acc[3][3]); \
        __builtin_amdgcn_s_setprio(0); }
#define G_PRE(buf_) \
    const bf16_t* as_ = As + (buf_) * 256 * 64 + (wm * 64 + fr) * 64; const bf16_t* bs_ = Bs + (buf_) * 128 * 64 + (wn * 64 + fr) * 64; \
    const int so0_ = ((fq) ^ (fr >> 1)) << 3, so1_ = ((4 | fq) ^ (fr >> 1)) << 3; \
    const bf16x8 fa0 = *(const bf16x8*)(as_ + so0_), fa1 = *(const bf16x8*)(as_ + 16 * 64 + so0_), fa2 = *(const bf16x8*)(as_ + 32 * 64 + so0_), fa3 = *(const bf16x8*)(as_ + 48 * 64 + so0_); \
    const bf16x8 fb0 = *(const bf16x8*)(bs_ + so0_), fb1 = *(const bf16x8*)(bs_ + 16 * 64 + so0_), fb2 = *(const bf16x8*)(bs_ + 32 * 64 + so0_), fb3 = *(const bf16x8*)(bs_ + 48 * 64 + so0_);
#define G_MID() G_MFMA16(fa0, fa1, fa2, fa3, fb0, fb1, fb2, fb3)
#define G_RD1() \
    const bf16x8 ga0 = *(const bf16x8*)(as_ + so1_), ga1 = *(const bf16x8*)(as_ + 16 * 64 + so1_), ga2 = *(const bf16x8*)(as_ + 32 * 64 + so1_), ga3 = *(const bf16x8*)(as_ + 48 * 64 + so1_); \
    const bf16x8 gb0 = *(const bf16x8*)(bs_ + so1_), gb1 = *(const bf16x8*)(bs_ + 16 * 64 + so1_), gb2 = *(const bf16x8*)(bs_ + 32 * 64 + so1_), gb3 = *(const bf16x8*)(bs_ + 48 * 64 + so1_);
#define G_POST() G_MFMA16(ga0, ga1, ga2, ga3, gb0, gb1, gb2, gb3)
        if (!primed_) { G_LOAD(p, 0) G_LOAD(q, 1) }
        __syncthreads();
        G_STORE(p, 0)
        if (2 < nkk) G_LOAD(p, 2) else if (nok_) G_LOADN(p, 0)
        for (int kt = 0; kt < nkk; kt += 2) {
            __syncthreads();
            {
                G_PRE(0)
                G_MID()
                G_RD1()
                G_STORE(q, 1)
                if (kt + 3 < nkk) G_LOAD(q, kt + 3) else if (nok_) G_LOADN(q, 1)
                G_POST()
            }
            __syncthreads();
            {
                G_PRE(1)
                G_MID()
                G_RD1()
                if (kt + 2 < nkk) { G_STORE(p, 0) if (kt + 4 < nkk) G_LOAD(p, kt + 4) else if (nok_) G_LOADN(p, 0) }
                G_POST()
            }
        }
        primed_ = nok_;
        { int ln = lane; asm volatile("" : "+v"(ln));
          if constexpr (SPLIT) { if (atom_) epi.atom(acc, tm * 256 + wm * 64, tn * 128 + wn * 64, ln); else epi(acc, tm * 256 + wm * 64, tn * 128 + wn * 64, ln); }
          else epi(acc, tm * 256 + wm * 64, tn * 128 + wn * 64, ln); }
    }
}

__device__ __forceinline__ void epi_store_cols_bf16(f32x4 (&acc)[4][4], bf16_t* __restrict__ dstT, size_t ldT, int lane) {
    extern __shared__ __attribute__((aligned(16))) unsigned char smem_e[];
    bf16_t* st = (bf16_t*)(smem_e + 98304 + (threadIdx.x >> 6) * 4608);
    const int fr = lane & 15, fq = lane >> 4;
#pragma unroll
    for (int half = 0; half < 2; ++half) {
#pragma unroll
        for (int n2 = 0; n2 < 2; ++n2)
#pragma unroll
            for (int mt = 0; mt < 4; ++mt) { const f32x4 a = acc[mt][half * 2 + n2]; uint2 pk; pk.x = pk2(a[0], a[1]); pk.y = pk2(a[2], a[3]); *(uint2*)(st + (n2 * 16 + fr) * 72 + mt * 16 + fq * 4) = pk; }
#pragma unroll
        for (int i = 0; i < 4; ++i) { const int pc = lane + 64 * i; const int c = pc >> 3, ch = pc & 7;
            *(uint4*)(dstT + (size_t)(half * 32 + c) * ldT + ch * 8) = *(const uint4*)(st + c * 72 + ch * 8); }
    }
}

struct EpiWin {
    bf16_t *u, *qr, *kr, *vT;
    __device__ __forceinline__ void operator()(f32x4 (&acc)[4][4], int row0, int col0, int lane) const {
        const int fr = lane & 15, fq = lane >> 4;
        if (col0 < 1536) {
#pragma unroll
            for (int mt = 0; mt < 4; ++mt)
#pragma unroll
                for (int nt = 0; nt < 4; ++nt)
#pragma unroll
                    for (int j = 0; j < 4; ++j) u[(size_t)(row0 + mt * 16 + fq * 4 + j) * 1536 + col0 + nt * 16 + fr] = f2bf(acc[mt][nt][j]);
        } else if (col0 < 2176) {
            const bool isq = col0 < 2048;
            const int hc = isq ? (col0 - 1536) : (col0 - 2048);
            bf16_t* dst = isq ? qr : kr; const int ld = isq ? 512 : 128; const float sc = isq ? 0.125f : 1.f;
            const float inv = exp2f(-(float)fr * (13.287712379549449f / 16.f));
#pragma unroll
            for (int mt = 0; mt < 4; ++mt)
#pragma unroll
                for (int j = 0; j < 4; ++j) {
                    const int row = row0 + mt * 16 + fq * 4 + j; const int s = row % RB;
                    float v0 = acc[mt][0][j], v1 = acc[mt][1][j], v2 = acc[mt][2][j], v3 = acc[mt][3][j];
                    if (s < SEQ) {
                        float sr, cr, sc2, cc; fast_sincos((float)(s >> 6) * inv, sr, cr); fast_sincos((float)(s & 63) * inv, sc2, cc);
                        const float a0 = v0 * cr - v1 * sr, a1 = v1 * cr + v0 * sr, a2 = v2 * cc - v3 * sc2, a3 = v3 * cc + v2 * sc2;
                        v0 = a0; v1 = a1; v2 = a2; v3 = a3;
                    }
                    bf16_t* o = dst + (size_t)row * ld + hc + fr;
                    o[0] = f2bf(v0 * sc); o[16] = f2bf(v1 * sc); o[32] = f2bf(v2 * sc); o[48] = f2bf(v3 * sc);
                }
        } else {
            const int hc = col0 - 2176;
            epi_store_cols_bf16(acc, vT + (size_t)hc * MROWS + row0, (size_t)MROWS, lane);
        }
    }
};
struct EpiRes0 {
    const float *srcl, *srcc; float *dstl, *dstc; const float* mod; int goff;
    __device__ __forceinline__ void operator()(f32x4 (&acc)[4][4], int row0, int col0, int lane) const {
        const int fr = lane & 15, fq = lane >> 4;
        const int b = row0 / RB; const int i0 = row0 % RB; const bool lat = i0 < SEQ;
        const float* g = mod + (lat ? b : 2) * 6144 + goff;
        float gv[4];
#pragma unroll
        for (int nt = 0; nt < 4; ++nt) gv[nt] = g[col0 + nt * 16 + fr];
        const size_t base0 = lat ? ((size_t)(b * SEQ + i0 + fq * 4) * D) : ((size_t)(b * CTXL + i0 - SEQ + fq * 4) * D);
        const float* s0 = (lat ? srcl : srcc) + base0 + col0 + fr; float* d0 = (lat ? dstl : dstc) + base0 + col0 + fr;
#pragma unroll
        for (int mt = 0; mt < 4; ++mt) {
            float sv[4][4];
#pragma unroll
            for (int j = 0; j < 4; ++j)
#pragma unroll
                for (int nt = 0; nt < 4; ++nt) sv[j][nt] = s0[(size_t)(mt * 16 + j) * D + nt * 16];
#pragma unroll
            for (int j = 0; j < 4; ++j)
#pragma unroll
                for (int nt = 0; nt < 4; ++nt) d0[(size_t)(mt * 16 + j) * D + nt * 16] = sv[j][nt] + gv[nt] * acc[mt][nt][j];
        }
    }
    __device__ __forceinline__ void atom(f32x4 (&acc)[4][4], int row0, int col0, int lane) const {
        const int fr = lane & 15, fq = lane >> 4;
        const int b = row0 / RB; const int i0 = row0 % RB; const bool lat = i0 < SEQ;
        const float* g = mod + (lat ? b : 2) * 6144 + goff;
#pragma unroll
        for (int mt = 0; mt < 4; ++mt)
#pragma unroll
            for (int j = 0; j < 4; ++j) {
                const int i = i0 + mt * 16 + fq * 4 + j;
                const size_t base = lat ? ((size_t)(b * SEQ + i) * D) : ((size_t)(b * CTXL + i - SEQ) * D);
                float* d = (lat ? dstl : dstc) + base;
#pragma unroll
                for (int nt = 0; nt < 4; ++nt) { const int col = col0 + nt * 16 + fr; atomicAdd(&d[col], g[col] * acc[mt][nt][j]); }
            }
    }
};
struct EpiRelu2 {
    bf16_t* h; int ld;
    __device__ __forceinline__ void operator()(f32x4 (&acc)[4][4], int row0, int col0, int lane) const {
        const int fr = lane & 15, fq = lane >> 4;
#pragma unroll
        for (int mt = 0; mt < 4; ++mt)
#pragma unroll
            for (int nt = 0; nt < 4; ++nt)
#pragma unroll
                for (int j = 0; j < 4; ++j) { float v = fmaxf(acc[mt][nt][j], 0.f); h[(size_t)(row0 + mt * 16 + fq * 4 + j) * ld + col0 + nt * 16 + fr] = f2bf(v * v); }
    }
};
struct EpiResLat {
    float* dst; const float* mod; int goff; int rowoff;
    __device__ __forceinline__ void operator()(f32x4 (&acc)[4][4], int row0, int col0, int lane) const {
        const int fr = lane & 15, fq = lane >> 4;
        const int r0 = row0 + rowoff; const float* g = mod + (r0 / SEQ) * 6144 + goff;
        float gv[4];
#pragma unroll
        for (int nt = 0; nt < 4; ++nt) gv[nt] = g[col0 + nt * 16 + fr];
        float* d0 = dst + (size_t)(r0 + fq * 4) * D + col0 + fr;
#pragma unroll
        for (int mt = 0; mt < 4; ++mt) {
            float sv[4][4];
#pragma unroll
            for (int j = 0; j < 4; ++j)
#pragma unroll
                for (int nt = 0; nt < 4; ++nt) sv[j][nt] = d0[(size_t)(mt * 16 + j) * D + nt * 16];
#pragma unroll
            for (int j = 0; j < 4; ++j)
#pragma unroll
                for (int nt = 0; nt < 4; ++nt) d0[(size_t)(mt * 16 + j) * D + nt * 16] = sv[j][nt] + gv[nt] * acc[mt][nt][j];
        }
    }
};
struct EpiRet {
    bf16_t *q1, *kz, *v1, *sg; const float* lrate;
    __device__ __forceinline__ void operator()(f32x4 (&acc)[4][4], int row0, int col0, int lane) const {
        const int fr = lane & 15, fq = lane >> 4;
        if (col0 < 2048) {
            const bool isq = col0 < 1024;
            if (isq && row0 >= SEQ) return;
            const int cc = isq ? col0 : col0 - 1024; const int h = cc >> 8, nb = cc & 255;
            const float lgf = -__expf(lrate[h]), lgb = -__expf(lrate[4 + h]);
            extern __shared__ __attribute__((aligned(16))) unsigned char smem_k[];
            bf16_t* kst = (bf16_t*)(smem_k + 98304 + (threadIdx.x >> 6) * 4608);
            const bool latT = row0 < SEQ;
            const int lr00 = row0 + fq * 4;
            const float pf0 = latT ? (float)(256 + lr00) : (float)(lr00 - SEQ);
            const float Cc = latT ? 8703.f : 255.f;
            const int a0 = lr00 & 127;
            const float ef0 = 0.0625f * __expf((float)(127 - a0) * lgf), eb0 = 0.0625f * __expf((float)a0 * lgb);
            const float efs = __expf(-lgf), ebs = __expf(lgb), efs16 = __expf(-16.f * lgf), ebs16 = __expf(16.f * lgb);
#pragma unroll
            for (int pr = 0; pr < 2; ++pr) {
                const int f = ((nb + pr * 32) >> 5) * 16 + fr;
                const float inv = exp2f(-(float)f * (13.287712379549449f / 127.f));
                float s1, c1, s16, c16, sC, cC, sm, cm;
                fast_sincos(inv, s1, c1); fast_sincos(16.f * inv, s16, c16); fast_sincos(Cc * inv, sC, cC); fast_sincos(pf0 * inv, sm, cm);
                float efm = ef0, ebm = eb0;
                uint2 kbp1[4], kbp2[4];
#pragma unroll
                for (int mt = 0; mt < 4; ++mt) { kbp1[mt] = make_uint2(0, 0); kbp2[mt] = kbp1[mt]; }
#pragma unroll
                for (int mt = 0; mt < 4; ++mt) {
                    float of1[4], of2[4], ob1[4], ob2[4];
                    float sf = sm, cf = cm, mf = efm, mb = ebm;
#pragma unroll
                    for (int j = 0; j < 4; ++j) {
                        const float x1 = acc[mt][2 * pr][j], x2 = acc[mt][2 * pr + 1][j];
                        const float cb = cC * cf + sC * sf, sb = sC * cf - cC * sf;
                        const float wf = isq ? 1.f : mf, wb = isq ? 1.f : mb;
                        of1[j] = (x1 * cf - x2 * sf) * wf; of2[j] = (x2 * cf + x1 * sf) * wf;
                        ob1[j] = (x1 * cb - x2 * sb) * wb; ob2[j] = (x2 * cb + x1 * sb) * wb;
                        const float cn = cf * c1 - sf * s1, sn = sf * c1 + cf * s1; cf = cn; sf = sn;
                        mf *= efs; mb *= ebs;
                    }
                    { const float cn = cm * c16 - sm * s16, sn = sm * c16 + cm * s16; cm = cn; sm = sn; efm *= efs16; ebm *= ebs16; }
                    const int lr0 = row0 + mt * 16 + fq * 4;
                    if (isq) {
#pragma unroll
                        for (int j = 0; j < 4; ++j) {
                            bf16_t* of = q1 + (size_t)(lr0 + j) * 1024 + h * 256 + f; bf16_t* ob = of + (size_t)SEQ * 1024;
                            of[0] = f2bf(of1[j]); of[128] = f2bf(of2[j]); ob[0] = f2bf(ob1[j]); ob[128] = f2bf(ob2[j]);
                        }
                    } else {
                        uint2 t;
                        t.x = pk2(of1[0], of1[1]); t.y = pk2(of1[2], of1[3]); *(uint2*)(kst + fr * 72 + mt * 16 + fq * 4) = t;
                        t.x = pk2(of2[0], of2[1]); t.y = pk2(of2[2], of2[3]); *(uint2*)(kst + (16 + fr) * 72 + mt * 16 + fq * 4) = t;
                        kbp1[mt].x = pk2(ob1[0], ob1[1]); kbp1[mt].y = pk2(ob1[2], ob1[3]); kbp2[mt].x = pk2(ob2[0], ob2[1]); kbp2[mt].y = pk2(ob2[2], ob2[3]);
                    }
                }
                if (!isq) {
                    const int f0 = ((nb + pr * 32) >> 5) * 16;
                    bf16_t* kdst = kz + (size_t)(h * 256 + f0) * RB + row0;
#pragma unroll
                    for (int i = 0; i < 4; ++i) { const int pc = lane + 64 * i; const int c = pc >> 3, ch = pc & 7;
                        *(uint4*)(kdst + (size_t)((c & 15) + (c >> 4) * 128) * RB + ch * 8) = *(const uint4*)(kst + c * 72 + ch * 8); }
#pragma unroll
                    for (int mt = 0; mt < 4; ++mt) { *(uint2*)(kst + fr * 72 + mt * 16 + fq * 4) = kbp1[mt]; *(uint2*)(kst + (16 + fr) * 72 + mt * 16 + fq * 4) = kbp2[mt]; }
                    kdst += (size_t)1024 * RB;
#pragma unroll
                    for (int i = 0; i < 4; ++i) { const int pc = lane + 64 * i; const int c = pc >> 3, ch = pc & 7;
                        *(uint4*)(kdst + (size_t)((c & 15) + (c >> 4) * 128) * RB + ch * 8) = *(const uint4*)(kst + c * 72 + ch * 8); }
                }
            }
        } else if (col0 < 4096) {
            const int vc = col0 - 2048;
            epi_store_cols_bf16(acc, v1 + (size_t)vc * RB + row0, (size_t)RB, lane);
        } else {
            if (row0 >= SEQ) return;
            const int dir = col0 >= 6144; const int gc = col0 - 4096 - dir * 2048;
            bf16_t* dst = sg + (size_t)dir * SEQ * 2048;
#pragma unroll
            for (int mt = 0; mt < 4; ++mt)
#pragma unroll
                for (int nt = 0; nt < 4; ++nt)
#pragma unroll
                    for (int j = 0; j < 4; ++j) dst[(size_t)(row0 + mt * 16 + fq * 4 + j) * 2048 + gc + nt * 16 + fr] = f2bf(siluf(acc[mt][nt][j]));
        }
    }
};

__device__ __forceinline__ void convert_w(const float* __restrict__ src, bf16_t* __restrict__ dst, int K, int N, int unit, bool perm, unsigned char* smem) {
    float* t = (float*)smem;
    const int tid = threadIdx.x; const int nkb = K / 64; const int kb = unit % nkb, nb = unit / nkb;
    __syncthreads();
#pragma unroll
    for (int i = 0; i < 2; ++i) {
        const int k = (tid >> 4) + 32 * i, n = (tid & 15) * 4;
        const float4 v = *(const float4*)(src + (size_t)(kb * 64 + k) * N + nb * 64 + n);
        t[k * 65 + n] = v.x; t[k * 65 + n + 1] = v.y; t[k * 65 + n + 2] = v.z; t[k * 65 + n + 3] = v.w;
    }
    __syncthreads();
    const int n = tid >> 3, k0 = (tid & 7) * 8;
    int no = nb * 64 + n;
    if (perm && no < 2048) { const int hb = no & ~255, d = no & 255; const int half = d >> 7, ip = d & 127; no = hb + (ip >> 4) * 32 + half * 16 + (ip & 15); }
    uint4 o;
    o.x = pk2(t[(k0 + 0) * 65 + n], t[(k0 + 1) * 65 + n]); o.y = pk2(t[(k0 + 2) * 65 + n], t[(k0 + 3) * 65 + n]);
    o.z = pk2(t[(k0 + 4) * 65 + n], t[(k0 + 5) * 65 + n]); o.w = pk2(t[(k0 + 6) * 65 + n], t[(k0 + 7) * 65 + n]);
    *(uint4*)(dst + (size_t)no * K + kb * 64 + k0) = o;
}

__device__ __forceinline__ void mod_unit(const Params& p, int unit, unsigned char* smem) {
    float* sc = (float*)smem;
    float* red = sc + 3072;
    const int tid = threadIdx.x, lane = tid & 63, w = tid >> 6;
    const int layer = unit / 96, n0 = (unit % 96) * 64;
    __syncthreads();
    for (int i = tid; i < 3072; i += NT) { const int v = i >> 10, k = i & 1023; const float cv = v < 2 ? p.c[v * 1024 + k] : p.c_ctx[k]; sc[i] = siluf(cv); }
    __syncthreads();
    const float* W = p.ada_w + (size_t)layer * 1024 * 6144 + n0 + lane;
    float a0 = 0.f, a1 = 0.f, a2 = 0.f;
#pragma unroll 8
    for (int k = w * 128; k < w * 128 + 128; ++k) { const float wv = W[(size_t)k * 6144]; a0 += sc[k] * wv; a1 += sc[1024 + k] * wv; a2 += sc[2048 + k] * wv; }
    red[(w * 3 + 0) * 64 + lane] = a0; red[(w * 3 + 1) * 64 + lane] = a1; red[(w * 3 + 2) * 64 + lane] = a2;
    __syncthreads();
    if (tid < 192) {
        const int v = tid >> 6; float s = 0.f;
        for (int ww = 0; ww < 8; ++ww) s += red[(ww * 3 + v) * 64 + lane];
        float* mod = (float*)(p.ws + OFF_MOD);
        mod[(layer * 3 + v) * 6144 + n0 + lane] = s + p.ada_b[layer * 6144 + n0 + lane];
    }
}

__device__ __forceinline__ void filter_unit(const Params& p, int L, int j0, float* hT, float* pn, unsigned char* smem) {
    float* zf = (float*)smem;
    float* h1 = zf + 32 * 36;
    float* h2 = h1 + 32 * 64;
    float* w1s = h2 + 32 * 64;
    float* w2s = w1s + 33 * 64;
    float* bfs = w2s + 64 * 64;
    const int tid = threadIdx.x;
    __syncthreads();
    for (int i = tid; i < 33 * 64; i += NT) w1s[i] = p.hy_w1[i];
    for (int i = tid; i < 64 * 64; i += NT) w2s[i] = p.hy_w2[i];
    if (tid < 64) { bfs[tid] = p.hy_b1[tid]; bfs[64 + tid] = p.hy_b2[tid]; bfs[128 + tid] = p.hy_freq[tid]; }
    for (int i = tid; i < 32 * 33; i += NT) {
        const int r = i / 33, f = i % 33; const float t = (float)(j0 + r) / (float)L; float v;
        if (f == 0) v = t;
        else { const int kb = (f - 1) & 15; const float band = 1e-4f + (float)kb * ((15.f - 1e-4f) / 15.f); const float ang = 6.283185307179586f * t * band; float s, c; fast_sincos(ang, s, c); v = (f <= 16) ? c : -s; }
        zf[r * 36 + f] = v;
    }
    __syncthreads();
    {
        const int r = tid >> 4, o0 = (tid & 15) * 4;
        float a0 = bfs[o0], a1 = bfs[o0 + 1], a2 = bfs[o0 + 2], a3 = bfs[o0 + 3];
#pragma unroll 11
        for (int f = 0; f < 33; ++f) { const float z = zf[r * 36 + f]; const float4 w = *(const float4*)(w1s + f * 64 + o0); a0 += z * w.x; a1 += z * w.y; a2 += z * w.z; a3 += z * w.w; }
        float s_, c_;
        fast_sincos(bfs[128 + o0] * a0, s_, c_); h1[r * 64 + o0] = s_; fast_sincos(bfs[128 + o0 + 1] * a1, s_, c_); h1[r * 64 + o0 + 1] = s_;
        fast_sincos(bfs[128 + o0 + 2] * a2, s_, c_); h1[r * 64 + o0 + 2] = s_; fast_sincos(bfs[128 + o0 + 3] * a3, s_, c_); h1[r * 64 + o0 + 3] = s_;
    }
    __syncthreads();
    {
        const int r = tid >> 4, o0 = (tid & 15) * 4;
        float a0 = bfs[64 + o0], a1 = bfs[64 + o0 + 1], a2 = bfs[64 + o0 + 2], a3 = bfs[64 + o0 + 3];
#pragma unroll 16
        for (int f = 0; f < 64; ++f) { const float z = h1[r * 64 + f]; const float4 w = *(const float4*)(w2s + f * 64 + o0); a0 += z * w.x; a1 += z * w.y; a2 += z * w.z; a3 += z * w.w; }
        float s_, c_;
        fast_sincos(bfs[128 + o0] * a0, s_, c_); h2[r * 64 + o0] = s_; fast_sincos(bfs[128 + o0 + 1] * a1, s_, c_); h2[r * 64 + o0 + 1] = s_;
        fast_sincos(bfs[128 + o0 + 2] * a2, s_, c_); h2[r * 64 + o0 + 2] = s_; fast_sincos(bfs[128 + o0 + 3] * a3, s_, c_); h2[r * 64 + o0 + 3] = s_;
    }
    __syncthreads();
    for (int cc = 0; cc < 2; ++cc) {
        const int col = tid + cc * 512;
        float wr[64];
#pragma unroll
        for (int k = 0; k < 64; ++k) wr[k] = p.hy_w3[k * 1024 + col];
        const float dec = fabsf(p.hy_decay[col]); float ss = 0.f;
        float* dst = hT + (size_t)col * L + j0;
#pragma unroll 1
        for (int rb = 0; rb < 32; rb += 4) {
            float a0 = 0.f, a1 = 0.f, a2 = 0.f, a3 = 0.f;
#pragma unroll
            for (int k4 = 0; k4 < 64; k4 += 4) {
                const float4 h0 = *(const float4*)(h2 + (rb + 0) * 64 + k4), h1v = *(const float4*)(h2 + (rb + 1) * 64 + k4), h2v = *(const float4*)(h2 + (rb + 2) * 64 + k4), h3v = *(const float4*)(h2 + (rb + 3) * 64 + k4);
                a0 += h0.x * wr[k4] + h0.y * wr[k4 + 1] + h0.z * wr[k4 + 2] + h0.w * wr[k4 + 3];
                a1 += h1v.x * wr[k4] + h1v.y * wr[k4 + 1] + h1v.z * wr[k4 + 2] + h1v.w * wr[k4 + 3];
                a2 += h2v.x * wr[k4] + h2v.y * wr[k4 + 1] + h2v.z * wr[k4 + 2] + h2v.w * wr[k4 + 3];
                a3 += h3v.x * wr[k4] + h3v.y * wr[k4 + 1] + h3v.z * wr[k4 + 2] + h3v.w * wr[k4 + 3];
            }
            const float invL = 1.f / (float)L;
            a0 *= __expf(-(float)(j0 + rb) * invL * dec); a1 *= __expf(-(float)(j0 + rb + 1) * invL * dec); a2 *= __expf(-(float)(j0 + rb + 2) * invL * dec); a3 *= __expf(-(float)(j0 + rb + 3) * invL * dec);
            if (!(cc == 1 && j0 + rb == 0)) ss += a0 * a0;
            ss += a1 * a1 + a2 * a2 + a3 * a3;
            *(float4*)(dst + rb) = make_float4(a0, a1, a2, a3);
        }
        pn[col] = ss;
    }
}

__device__ __forceinline__ void normmod_row(const float* __restrict__ src, const float* __restrict__ g, const float* __restrict__ sh, const float* __restrict__ sc, bf16_t* __restrict__ dst, int lane) {
    float4 v[4]; float ss = 0.f;
#pragma unroll
    for (int i = 0; i < 4; ++i) { v[i] = *(const float4*)(src + i * 256 + lane * 4); ss += v[i].x * v[i].x + v[i].y * v[i].y + v[i].z * v[i].z + v[i].w * v[i].w; }
#pragma unroll
    for (int o = 32; o >= 1; o >>= 1) ss += __shfl_xor(ss, o);
    const float rs = rsqrtf(ss * (1.f / 1024.f) + 1e-6f);
#pragma unroll
    for (int i = 0; i < 4; ++i) {
        const int c0 = i * 256 + lane * 4;
        const float4 gg = *(const float4*)(g + c0), s1 = *(const float4*)(sh + c0), s2 = *(const float4*)(sc + c0);
        uint2 o; o.x = pk2(v[i].x * rs * gg.x * (1.f + s2.x) + s1.x, v[i].y * rs * gg.y * (1.f + s2.y) + s1.y);
        o.y = pk2(v[i].z * rs * gg.z * (1.f + s2.z) + s1.z, v[i].w * rs * gg.w * (1.f + s2.w) + s1.w);
        *(uint2*)(dst + c0) = o;
    }
}

struct RowMap {
    const float* lat; const float* ctx; int mode; int b;
    __device__ __forceinline__ const float* src(int r, int& vidx) const {
        if (mode == 2) { vidx = r / SEQ; return lat + (size_t)r * D; }
        const int bb = mode == 0 ? r / RB : b; const int i = mode == 0 ? r % RB : r;
        if (i < SEQ) { vidx = bb; return lat + (size_t)(bb * SEQ + i) * D; }
        vidx = 2; return ctx + (size_t)(bb * CTXL + i - SEQ) * D;
    }
};
__device__ __forceinline__ void normmod_phase(int M, const RowMap& rm, const float* __restrict__ g, const float* __restrict__ modl, int sh_off, int sc_off, bf16_t* __restrict__ dst, int gw, int nw, int lane) {
    const int per = (M + nw - 1) / nw; const int r0 = gw * per; const int r1 = (r0 + per < M) ? r0 + per : M;
    if (r0 >= r1) return;
    int curv = -1; float4 ca[4], cb[4];
    int vidx; const float* s = rm.src(r0, vidx);
    float4 v[4];
#pragma unroll
    for (int i = 0; i < 4; ++i) v[i] = *(const float4*)(s + i * 256 + lane * 4);
#pragma unroll 1
    for (int r = r0; r < r1; ++r) {
        float4 nv[4]; int nvidx = vidx;
        { const int rn = (r + 1 < r1) ? r + 1 : r; const float* ns = rm.src(rn, nvidx);
#pragma unroll
            for (int i = 0; i < 4; ++i) nv[i] = *(const float4*)(ns + i * 256 + lane * 4); }
        if (vidx != curv) {
            curv = vidx; const float* mv = modl + vidx * 6144;
#pragma unroll
            for (int i = 0; i < 4; ++i) { const int c0 = i * 256 + lane * 4; const float4 gg = *(const float4*)(g + c0), s1 = *(const float4*)(mv + sh_off + c0), s2 = *(const float4*)(mv + sc_off + c0);
                ca[i] = make_float4(gg.x * (1.f + s2.x), gg.y * (1.f + s2.y), gg.z * (1.f + s2.z), gg.w * (1.f + s2.w)); cb[i] = s1; }
        }
        float ss = 0.f;
#pragma unroll
        for (int i = 0; i < 4; ++i) ss += v[i].x * v[i].x + v[i].y * v[i].y + v[i].z * v[i].z + v[i].w * v[i].w;
#pragma unroll
        for (int o = 32; o >= 1; o >>= 1) ss += __shfl_xor(ss, o);
        const float rs = rsqrtf(ss * (1.f / 1024.f) + 1e-6f);
        bf16_t* d = dst + (size_t)r * D;
#pragma unroll
        for (int i = 0; i < 4; ++i) {
            uint2 o; o.x = pk2(v[i].x * rs * ca[i].x + cb[i].x, v[i].y * rs * ca[i].y + cb[i].y); o.y = pk2(v[i].z * rs * ca[i].z + cb[i].z, v[i].w * rs * ca[i].w + cb[i].w);
            *(uint2*)(d + i * 256 + lane * 4) = o;
        }
#pragma unroll
        for (int i = 0; i < 4; ++i) v[i] = nv[i];
        vidx = nvidx;
    }
}

__device__ __forceinline__ void fft_fwd(float2* X, const float2* __restrict__ tw, int tid) {
    for (int h = 8192; h >= 2; h >>= 2) {
        const int q = h >> 1, tsh = 8192 / h; const int lq = 31 - __clz(q);
        for (int g = tid; g < 4096; g += NT) {
            const int blk = g >> lq, off = g & (q - 1); const int base = blk * 2 * h + off;
            const float2 a = X[base], b = X[base + q], c = X[base + 2 * q], d = X[base + 3 * q];
            const float2 w1 = tw[off * tsh], w2 = tw[off * tsh * 2];
            const float2 a1 = cadd(a, c), c1 = cmul(csub(a, c), w1);
            const float2 b1 = cadd(b, d); const float2 t = csub(b, d); const float2 d1 = cmul(make_float2(t.y, -t.x), w1);
            X[base] = cadd(a1, b1); X[base + q] = cmul(csub(a1, b1), w2); X[base + 2 * q] = cadd(c1, d1); X[base + 3 * q] = cmul(csub(c1, d1), w2);
        }
        __syncthreads();
    }
}
__device__ __forceinline__ void fft_inv(float2* X, const float2* __restrict__ tw, int tid) {
    for (int h = 2; h <= 8192; h <<= 2) {
        const int q = h >> 1, tsh = 8192 / h; const int lq = 31 - __clz(q);
        for (int g = tid; g < 4096; g += NT) {
            const int blk = g >> lq, off = g & (q - 1); const int base = blk * 2 * h + off;
            const float2 a = X[base], b = X[base + q], c = X[base + 2 * q], d = X[base + 3 * q];
            float2 w1 = tw[off * tsh], w2 = tw[off * tsh * 2]; w1.y = -w1.y; w2.y = -w2.y;
            const float2 bb = cmul(b, w2), dd = cmul(d, w2);
            const float2 a1 = cadd(a, bb), b1 = csub(a, bb), c1 = cadd(c, dd), d1 = csub(c, dd);
            const float2 cc = cmul(c1, w1); const float2 t = cmul(d1, w1); const float2 d2 = make_float2(-t.y, t.x);
            X[base] = cadd(a1, cc); X[base + 2 * q] = csub(a1, cc); X[base + q] = cadd(b1, d2); X[base + 3 * q] = csub(b1, d2);
        }
        __syncthreads();
    }
}

__device__ __forceinline__ void attn_unit(const Params& p, int b, int kh, int half, int qrow0  , int nloc  , unsigned char* smem) {
    const bf16_t* qr = (const bf16_t*)(p.ws + OFF_QR); const bf16_t* kr = (const bf16_t*)(p.ws + OFF_KR); const bf16_t* vT = (const bf16_t*)(p.ws + OFF_VT);
    bf16_t* ao = (bf16_t*)(p.ws + OFF_AO);
    bf16_t* Ks = (bf16_t*)smem;
    bf16_t* Vs = Ks + 64 * 72;
    int tid = threadIdx.x; asm volatile("" : "+v"(tid));
    const int lane = tid & 63, w = tid >> 6, fr = lane & 15, fq = lane >> 4;
    const int g = half * 2 + (w >> 2), qq = w & 3, h = kh * 4 + g;
    const int myq0 = qrow0 + qq * 32;
    bf16x8 qf[2][2];
#pragma unroll
    for (int qt = 0; qt < 2; ++qt)
#pragma unroll
        for (int ks = 0; ks < 2; ++ks) qf[qt][ks] = *(const bf16x8*)(qr + (size_t)(myq0 + qt * 16 + fr) * 512 + h * 64 + ks * 32 + fq * 8);
    f32x4 o[2][4];
#pragma unroll
    for (int i = 0; i < 2; ++i)
#pragma unroll
        for (int j = 0; j < 4; ++j) o[i][j] = (f32x4){0.f, 0.f, 0.f, 0.f};
    const float sink = p.attn_sink[h];
    float m[2], l[2];
#pragma unroll
    for (int qt = 0; qt < 2; ++qt) { m[qt] = sink; l[qt] = 1.f; }
    int loc0 = 0, nlt = 0;
    if (nloc >= 0) { int lo = (nloc - 1) * 128; if (lo < 0) lo = 0; int hi = (nloc + 2) * 128; if (hi > SEQ) hi = SEQ; loc0 = lo; nlt = (hi - lo) / 64; }
    const int ntile = nlt + 4;
    const int sr_ = tid >> 3, sch_ = (tid & 7) * 8;
    uint4 kpre, vpre;
    { const int krow00 = nlt > 0 ? b * RB + loc0 : b * RB + SEQ;
      kpre = *(const uint4*)(kr + (size_t)(krow00 + sr_) * 128 + kh * 64 + sch_); vpre = *(const uint4*)(vT + (size_t)(kh * 64 + sr_) * MROWS + krow00 + sch_); }
#pragma unroll 1
    for (int t = 0; t < ntile; ++t) {
        const bool isloc = t < nlt;
        const int kpos0 = isloc ? loc0 + t * 64 : 0;
        __syncthreads();
        *(uint4*)(Ks + sr_ * 72 + sch_) = kpre; *(uint4*)(Vs + sr_ * 72 + sch_) = vpre;
        if (t + 1 < ntile) { const int t1 = t + 1; const int krow1 = t1 < nlt ? b * RB + loc0 + t1 * 64 : b * RB + SEQ + (t1 - nlt) * 64;
            kpre = *(const uint4*)(kr + (size_t)(krow1 + sr_) * 128 + kh * 64 + sch_); vpre = *(const uint4*)(vT + (size_t)(kh * 64 + sr_) * MROWS + krow1 + sch_); }
        __syncthreads();
        f32x4 st[4][2];
#pragma unroll
        for (int i = 0; i < 4; ++i)
#pragma unroll
            for (int j = 0; j < 2; ++j) st[i][j] = (f32x4){0.f, 0.f, 0.f, 0.f};
#pragma unroll
        for (int ks = 0; ks < 2; ++ks) {
#pragma unroll
            for (int kt = 0; kt < 4; ++kt) {
                const bf16x8 kf = *(const bf16x8*)(Ks + (kt * 16 + fr) * 72 + ks * 32 + fq * 8);
#pragma unroll
                for (int qt = 0; qt < 2; ++qt) st[kt][qt] = mfma16(kf, qf[qt][ks], st[kt][qt]);
            }
        }
        if (isloc) {
            const int qpb = nloc * 128 + qq * 32 + fr;
#pragma unroll
            for (int kt = 0; kt < 4; ++kt)
#pragma unroll
                for (int qt = 0; qt < 2; ++qt)
#pragma unroll
                    for (int j = 0; j < 4; ++j) { const int dlt = (qpb + qt * 16) - (kpos0 + kt * 16 + fq * 4 + j); if (dlt > 128 || dlt < -128) st[kt][qt][j] = -1e30f; }
        }
#pragma unroll
        for (int qt = 0; qt < 2; ++qt) {
            float mx = -3e38f;
#pragma unroll
            for (int kt = 0; kt < 4; ++kt)
#pragma unroll
                for (int j = 0; j < 4; ++j) mx = fmaxf(mx, st[kt][qt][j]);
            mx = fmaxf(mx, __shfl_xor(mx, 16)); mx = fmaxf(mx, __shfl_xor(mx, 32));
            const float mn = fmaxf(m[qt], mx); const float alpha = __expf(m[qt] - mn); m[qt] = mn;
            float sum = 0.f;
#pragma unroll
            for (int kt = 0; kt < 4; ++kt)
#pragma unroll
                for (int j = 0; j < 4; ++j) { const float sv = st[kt][qt][j]; const float pv = sv < -1e29f ? 0.f : __expf(sv - mn); st[kt][qt][j] = pv; sum += pv; }
            sum += __shfl_xor(sum, 16); sum += __shfl_xor(sum, 32);
            l[qt] = l[qt] * alpha + sum;
#pragma unroll
            for (int j = 0; j < 4; ++j) { const float al = __shfl(alpha, fq * 4 + j);
#pragma unroll
                for (int dt = 0; dt < 4; ++dt) o[qt][dt][j] *= al; }
        }
#pragma unroll
        for (int ks = 0; ks < 2; ++ks) {
            bf16x8 pf[2];
#pragma unroll
            for (int qt = 0; qt < 2; ++qt) {
                uint4 u4; u4.x = pk2(st[2 * ks][qt][0], st[2 * ks][qt][1]); u4.y = pk2(st[2 * ks][qt][2], st[2 * ks][qt][3]);
                u4.z = pk2(st[2 * ks + 1][qt][0], st[2 * ks + 1][qt][1]); u4.w = pk2(st[2 * ks + 1][qt][2], st[2 * ks + 1][qt][3]);
                pf[qt] = __builtin_bit_cast(bf16x8, u4);
            }
#pragma unroll
            for (int dt = 0; dt < 4; ++dt) {
                const uint2 lo = *(const uint2*)(Vs + (dt * 16 + fr) * 72 + ks * 32 + fq * 4);
                const uint2 hi = *(const uint2*)(Vs + (dt * 16 + fr) * 72 + ks * 32 + 16 + fq * 4);
                const bf16x8 vf = __builtin_bit_cast(bf16x8, make_uint4(lo.x, lo.y, hi.x, hi.y));
#pragma unroll
                for (int qt = 0; qt < 2; ++qt) o[qt][dt] = mfma16(pf[qt], vf, o[qt][dt]);
            }
        }
    }
#pragma unroll
    for (int qt = 0; qt < 2; ++qt) {
        const float il = 1.f / l[qt];
#pragma unroll
        for (int j = 0; j < 4; ++j) {
            const float s = __shfl(il, fq * 4 + j);
            bf16_t* dst = ao + (size_t)(myq0 + qt * 16 + fq * 4 + j) * 1024 + 512 + h * 64 + fr;
#pragma unroll
            for (int dt = 0; dt < 4; ++dt) dst[dt * 16] = f2bf(o[qt][dt][j] * s);
        }
    }
}


#define XB_TMO      128
#define XB_XCNT(j)  (256  + 64 * (j))
#define XB_XSUB(j)  (1280 + 64 * (j))
#define XB_XGEN(j)  (2304 + 64 * (j))
#define XB_TOP      3328
#define XB_TOPGEN   3392
#define XCD_BAR_WORDS 3456
#define XB_SPIN_CAP (1u << 20)
#define LAS __attribute__((address_space(3)))
__device__ __forceinline__ unsigned xb_ld(unsigned* p)              { return __hip_atomic_load(p, __ATOMIC_RELAXED, __HIP_MEMORY_SCOPE_AGENT); }
__device__ __forceinline__ unsigned xb_add(unsigned* p, unsigned v) { return __hip_atomic_fetch_add(p, v, __ATOMIC_RELAXED, __HIP_MEMORY_SCOPE_AGENT); }
__device__ __forceinline__ unsigned xb_xcc_id() { return (unsigned)__builtin_amdgcn_s_getreg((3 << 11) | 20) & 0xFu; }
#define XB_SPIN(cond, bar) do { unsigned _sp = 0; while (cond) { __builtin_amdgcn_s_sleep(1); \
    if ((++_sp & 255u) == 0u) { if (xb_ld(&(bar)[XB_TMO])) break; if (_sp > XB_SPIN_CAP) { atomicAdd(&(bar)[XB_TMO], 1u); break; } } } } while (0)
struct XcdBarrier { unsigned* bar; unsigned x; volatile LAS unsigned* st; };
__device__ __forceinline__ XcdBarrier xcd_barrier_post(unsigned* bar, volatile LAS unsigned* st) {
    XcdBarrier b; b.bar = bar; b.x = xb_xcc_id(); b.st = st;
    if (threadIdx.x == 0) (void)xb_add(&bar[XB_XCNT(b.x)], 1u);
    return b;
}
__device__ __forceinline__ void xcd_barrier_complete(unsigned* bar, unsigned x, unsigned& nloc, unsigned& nx) {
    const unsigned G = gridDim.x * gridDim.y * gridDim.z;
    unsigned sum, cnt, mine, sp = 0u;
    for (;;) {
        sum = 0u; cnt = 0u; mine = 0u;
#pragma unroll
        for (unsigned j = 0; j < 16; ++j) { const unsigned c = xb_ld(&bar[XB_XCNT(j)]); sum += c; cnt += (c > 0u) ? 1u : 0u; mine = (j == x) ? c : mine; }
        if (sum == G) break;
        __builtin_amdgcn_s_sleep(1);
        if ((++sp & 255u) == 0u) { if (xb_ld(&bar[XB_TMO])) break; if (sp > XB_SPIN_CAP) { atomicAdd(&bar[XB_TMO], 1u); break; } }
    }
    nloc = mine > 0u ? mine : 1u; nx = cnt > 0u ? cnt : 1u;
}
__device__ __forceinline__ void xcd_barrier(const XcdBarrier& b) {
    asm volatile("s_waitcnt vmcnt(0)" ::: "memory");
    __syncthreads();
    if (threadIdx.x == 0) {
        unsigned* bar = b.bar;
        __builtin_amdgcn_s_waitcnt(0);
        unsigned nloc = b.st[0], nx = b.st[1];
        if (nloc == 0u) { xcd_barrier_complete(bar, b.x, nloc, nx); b.st[0] = nloc; b.st[1] = nx; }
        const unsigned old = xb_add(&bar[XB_XSUB(b.x)], 1u);
        const unsigned gen = old / nloc;
        if (old + 1u == (gen + 1u) * nloc) {
            __builtin_amdgcn_fence(__ATOMIC_RELEASE, "agent");
            asm volatile("s_waitcnt vmcnt(0)" ::: "memory");
            const unsigned og = xb_add(&bar[XB_TOP], 1u);
            const unsigned tg = og / nx;
            if (og + 1u == (tg + 1u) * nx) xb_add(&bar[XB_TOPGEN], 1u);
            else XB_SPIN(xb_ld(&bar[XB_TOPGEN]) == tg, bar);
            __builtin_amdgcn_fence(__ATOMIC_ACQUIRE, "agent");
            xb_add(&bar[XB_XGEN(b.x)], 1u);
            asm volatile("s_waitcnt vmcnt(0)" ::: "memory");
        } else {
            XB_SPIN(xb_ld(&bar[XB_XGEN(b.x)]) == gen, bar);
            __builtin_amdgcn_fence(__ATOMIC_ACQUIRE, "agent");
            asm volatile("s_waitcnt vmcnt(0)" ::: "memory");
        }
    }
    __syncthreads();
}

__global__ void __launch_bounds__(NT) fwd_megakernel(Params p) {
    extern __shared__ __attribute__((aligned(16))) unsigned char smem[];
    cg::grid_group grid = cg::this_grid();
    __shared__ uint4 xb_words;
    if (threadIdx.x == 0) xb_words = make_uint4(0u, 0u, 0u, 0u);
    __syncthreads();
    const XcdBarrier xb = xcd_barrier_post((unsigned*)(p.ws + OFF_BAR), (volatile LAS unsigned*)&xb_words);
    const int tid = threadIdx.x, lane = tid & 63, wv = tid >> 6;
    const int nb = gridDim.x, bid = blockIdx.x;
    unsigned char* ws = p.ws;
    float* mod = (float*)(ws + OFF_MOD);
    float2* tw = (float2*)(ws + OFF_TW);
    float* xc = (float*)(ws + OFF_XC);
    bf16_t* Wt = (bf16_t*)(ws + OFF_WT);
    bf16_t* hA = (bf16_t*)(ws + OFF_HA);
    float* hT = (float*)(ws + OFF_HT); float* hTc = (float*)(ws + OFF_HTC); float* pn = (float*)(ws + OFF_PN);
    float2* Hf = (float2*)(ws + OFF_HF);
    bf16_t* ubuf = (bf16_t*)(ws + OFF_U);
    bf16_t* gT = (bf16_t*)(ws + OFF_GT); bf16_t* ao = (bf16_t*)(ws + OFF_AO); bf16_t* hid = (bf16_t*)(ws + OFF_HID);
    float* zT = (float*)((unsigned char*)p.out + DO_ZT); bf16_t* x0T = (bf16_t*)((unsigned char*)p.out + DO_X0T);

    {
        int tid = threadIdx.x; asm volatile("" : "+v"(tid)); const int lane = tid & 63, wv = tid >> 6; (void)lane; (void)wv;
        const int nW = 576 + 256 + 1024 + 1024;
        const int nU = nW + 192 + 16 + 256 + 8;
        for (int u = bid; u < nU; u += nb) {
            if (u < 576) convert_w(p.ev_w_in, Wt + W0_IN, 1024, 2304, u, false, smem);
            else if (u < 832) convert_w(p.ev_w_out, Wt + W0_OUT, 1024, 1024, u - 576, false, smem);
            else if (u < 1856) convert_w(p.mlp_w1, Wt + W0_1, 1024, 4096, u - 832, false, smem);
            else if (u < 2880) convert_w(p.mlp_w2, Wt + W0_2, 4096, 1024, u - 1856, false, smem);
            else if (u < nW + 192) mod_unit(p, u - nW, smem);
            else if (u < nW + 208) { const int k = (u - nW - 192) * 512 + tid; float s, c; sincospif((float)k / 8192.f, &s, &c); tw[k] = make_float2(c, -s); }
            else if (u < nW + 208 + 256) { const int fu = u - nW - 208; filter_unit(p, 8192, fu * 32, hT, pn + fu * 1024, smem); }
            else { const int fu = u - nW - 208 - 256; filter_unit(p, 256, fu * 32, hTc, pn + (256 + fu) * 1024, smem); }
        }
    }
    grid.sync();
    {
        int tid = threadIdx.x; asm volatile("" : "+v"(tid)); const int lane = tid & 63, wv = tid >> 6; (void)lane; (void)wv;
        const int nNorm = 0;
        { RowMap rm{p.x, p.ctx, 0, 0}; normmod_phase(MROWS, rm, p.norm_mix_g, mod, 0, 1024, hA, bid * 8 + wv, nb * 8, lane); }
        for (int u = bid; u < 256; u += nb) {
            {
                int tid = threadIdx.x; asm volatile("" : "+v"(tid)); const int lane = tid & 63, wv = tid >> 6;
                const int cA = u, cB = u + 256; float2* X = (float2*)smem; float* red = (float*)(smem + 131072);
                __syncthreads();
                float pa = 0.f, pb = 0.f;
                if (tid < 256) { pa = pn[tid * 1024 + cA] + pn[tid * 1024 + 512 + cA]; pb = pn[tid * 1024 + cB] + pn[tid * 1024 + 512 + cB]; }
#pragma unroll
                for (int o = 32; o >= 1; o >>= 1) { pa += __shfl_xor(pa, o); pb += __shfl_xor(pb, o); }
                if (lane == 0) { red[wv] = pa; red[8 + wv] = pb; }
                __syncthreads();
                float ta = 0.f, tb = 0.f; for (int i = 0; i < 8; ++i) { ta += red[i]; tb += red[8 + i]; }
                const float sa = 1.f / (sqrtf(ta) * 16384.f), sb = 1.f / (sqrtf(tb) * 16384.f);
                const float* a0 = hT + (size_t)cA * 8192; const float* a1 = hT + (size_t)(512 + cA) * 8192;
                const float* b0 = hT + (size_t)cB * 8192; const float* b1 = hT + (size_t)(512 + cB) * 8192;
#pragma unroll 1
                for (int m0 = tid; m0 < 8192; m0 += NT * 8) {
                    float pa_[8], pb_[8], na_[8], nb_[8];
#pragma unroll
                    for (int k = 0; k < 8; ++k) { const int m = m0 + k * NT; pa_[k] = a0[m]; pb_[k] = b0[m]; na_[k] = a1[m]; nb_[k] = b1[m]; }
#pragma unroll
                    for (int k = 0; k < 8; ++k) { const int m = m0 + k * NT; X[m] = make_float2(pa_[k] * sa, pb_[k] * sb); if (m > 0) X[16384 - m] = make_float2(na_[k] * sa, nb_[k] * sb); }
                }
                if (tid == 0) X[8192] = make_float2(0.f, 0.f);
                __syncthreads();
                fft_fwd(X, tw, tid);
                float2* dA = Hf + (size_t)cA * 16384; float2* dB = Hf + (size_t)cB * 16384;
                for (int mI = tid; mI < 16384; mI += NT) {
                    const int k = (int)(__brev((unsigned)mI) >> 18); const int m2 = (int)(__brev((unsigned)((16384 - k) & 16383)) >> 18);
                    const float2 x1 = X[mI], x2 = X[m2];
                    dA[mI] = make_float2(0.5f * (x1.x + x2.x), 0.5f * (x1.y - x2.y));
                    dB[mI] = make_float2(0.5f * (x1.y + x2.y), -0.5f * (x1.x - x2.x));
                }
            }
        }
    }
    xcd_barrier(xb);
    { EpiWin e{ubuf, (bf16_t*)(ws + OFF_QR), (bf16_t*)(ws + OFF_KR), (bf16_t*)(ws + OFF_VT)}; gemm_phase(hA, D, Wt + W0_IN, 1024, MROWS, 2304, 1024, e, smem); }
    xcd_barrier(xb);
    {
        int tid = threadIdx.x; asm volatile("" : "+v"(tid)); const int lane = tid & 63, wv = tid >> 6; (void)lane; (void)wv;
        float* zs = (float*)smem; float* xs = zs + 512 * 33;
        for (int u = bid; u < MROWS / 32; u += nb) {
            const int r0 = u * 32; const int i0 = r0 % RB; const int segEnd = (i0 < SEQ) ? SEQ : RB; const int segBeg = (i0 < SEQ) ? 0 : SEQ;
            const int c = tid;
            float w[3][3], bb[3];
#pragma unroll
            for (int gI = 0; gI < 3; ++gI) { bb[gI] = p.hy_conv_b[gI * 512 + c];
#pragma unroll
                for (int k = 0; k < 3; ++k) w[gI][k] = p.hy_conv_w[k * 1536 + gI * 512 + c]; }
            float prev[3], cur[3], nxt[3];
#pragma unroll
            for (int gI = 0; gI < 3; ++gI) { prev[gI] = (i0 > segBeg) ? bf2f(ubuf[(size_t)(r0 - 1) * 1536 + gI * 512 + c]) : 0.f; cur[gI] = bf2f(ubuf[(size_t)r0 * 1536 + gI * 512 + c]); }
            __syncthreads();
#pragma unroll 1
            for (int tb = 0; tb < 32; tb += 8) {
                bf16_t nx[8][3];
                const int lastr = segEnd - 1 - i0 + r0;
#pragma unroll
                for (int k = 0; k < 8; ++k) { int rr = r0 + tb + k + 1; rr = rr > lastr ? lastr : rr;
#pragma unroll
                    for (int gI = 0; gI < 3; ++gI) nx[k][gI] = ubuf[(size_t)rr * 1536 + gI * 512 + c]; }
#pragma unroll
                for (int k = 0; k < 8; ++k) {
                    const int t = tb + k; const bool hasn = (i0 + t + 1) < segEnd;
                    float cv[3];
#pragma unroll
                    for (int gI = 0; gI < 3; ++gI) { nxt[gI] = hasn ? bf2f(nx[k][gI]) : 0.f; cv[gI] = prev[gI] * w[gI][0] + cur[gI] * w[gI][1] + nxt[gI] * w[gI][2] + bb[gI]; prev[gI] = cur[gI]; cur[gI] = nxt[gI]; }
                    zs[c * 33 + t] = cv[2] * cv[1]; xs[c * 33 + t] = cv[0];
                }
            }
            __syncthreads();
            for (int i = tid; i < 512 * 8; i += NT) {
                const int cc = i >> 3, t4 = (i & 7) * 4;
                *(float4*)(zT + (size_t)cc * MROWS + r0 + t4) = make_float4(zs[cc * 33 + t4], zs[cc * 33 + t4 + 1], zs[cc * 33 + t4 + 2], zs[cc * 33 + t4 + 3]);
                uint2 o; o.x = pk2(xs[cc * 33 + t4], xs[cc * 33 + t4 + 1]); o.y = pk2(xs[cc * 33 + t4 + 2], xs[cc * 33 + t4 + 3]);
                *(uint2*)(x0T + (size_t)cc * MROWS + r0 + t4) = o;
            }
        }
    }
    xcd_barrier(xb);
    {
        int tid = threadIdx.x; asm volatile("" : "+v"(tid)); const int lane = tid & 63, wv = tid >> 6; (void)lane; (void)wv;
        for (int u = bid; u < 512 + 512 + 16 + 512; u += nb) {
            if (u < 512) {
                int tid = threadIdx.x; asm volatile("" : "+v"(tid));
                const int c = u; float2* X = (float2*)smem;
                const float* z0 = zT + (size_t)c * MROWS; const float* z1 = z0 + RB;
                __syncthreads();
#pragma unroll 1
                for (int m0 = tid; m0 < 8192; m0 += NT * 8) {
                    float ra[8], rb[8];
#pragma unroll
                    for (int k = 0; k < 8; ++k) { ra[k] = z0[m0 + k * NT]; rb[k] = z1[m0 + k * NT]; }
#pragma unroll
                    for (int k = 0; k < 8; ++k) { X[m0 + k * NT] = make_float2(ra[k], rb[k]); X[8192 + m0 + k * NT] = make_float2(0.f, 0.f); }
                }
                __syncthreads();
                fft_fwd(X, tw, tid);
                const float2* hf = Hf + (size_t)c * 16384;
#pragma unroll 1
                for (int m0 = tid; m0 < 16384; m0 += NT * 8) {
                    float2 hv[8];
#pragma unroll
                    for (int k = 0; k < 8; ++k) hv[k] = hf[m0 + k * NT];
#pragma unroll
                    for (int k = 0; k < 8; ++k) X[m0 + k * NT] = cmul(X[m0 + k * NT], hv[k]);
                }
                __syncthreads();
                fft_inv(X, tw, tid);
                const float bias = p.hy_bias[c];
                const bf16_t* xa = x0T + (size_t)c * MROWS; bf16_t* g0 = gT + (size_t)c * MROWS;
#pragma unroll 1
                for (int t0 = tid; t0 < 8192; t0 += NT * 4) {
                    bf16_t xa0[4], xa1[4]; float za[4], zb[4];
#pragma unroll
                    for (int k = 0; k < 4; ++k) { const int t = t0 + k * NT; xa0[k] = xa[t]; xa1[k] = xa[RB + t]; za[k] = z0[t]; zb[k] = z1[t]; }
#pragma unroll
                    for (int k = 0; k < 4; ++k) { const int t = t0 + k * NT; const float2 y = X[t];
                        g0[t] = f2bf(bf2f(xa0[k]) * (y.x + za[k] * bias)); g0[RB + t] = f2bf(bf2f(xa1[k]) * (y.y + zb[k] * bias)); }
                }
            } else if (u < 1024) {
                const int uu = u - 512; const int half = uu & 1, kh = (uu >> 1) & 1, n = (uu >> 2) & 63, b = uu >> 8;
                attn_unit(p, b, kh, half, b * RB + n * 128, n, smem);
            } else if (u < 1040) {
                const int uu = u - 1024; const int half = uu & 1, kh = (uu >> 1) & 1, qb = (uu >> 2) & 1, b = uu >> 3;
                attn_unit(p, b, kh, half, b * RB + SEQ + qb * 128, -1, smem);
            } else {
                int tid = threadIdx.x; asm volatile("" : "+v"(tid)); const int lane = tid & 63, wv = tid >> 6;
                const int c = u - 1040; float* hs = (float*)smem; float* zs = hs + 512; float* red = zs + 512;
                __syncthreads();
                float v = 0.f;
                { const int lag = tid - 255; if (tid < 511) v = lag >= 0 ? hTc[(size_t)c * 256 + lag] : hTc[(size_t)(512 + c) * 256 - lag]; }
                hs[tid] = v; float ss = v * v;
                { const int b = tid >> 8, s = tid & 255; zs[tid] = zT[(size_t)c * MROWS + b * RB + SEQ + s]; }
#pragma unroll
                for (int o = 32; o >= 1; o >>= 1) ss += __shfl_xor(ss, o);
                if (lane == 0) red[wv] = ss;
                __syncthreads();
                float tot = 0.f; for (int i = 0; i < 8; ++i) tot += red[i];
                const float inv = 1.f / sqrtf(tot);
                const int b = tid >> 8, t = tid & 255; float a = 0.f;
                for (int s = 0; s < 256; ++s) a += hs[t - s + 255] * zs[b * 256 + s];
                const size_t idx = (size_t)c * MROWS + b * RB + SEQ + t;
                gT[idx] = f2bf(bf2f(x0T[idx]) * (a * inv + zs[tid] * p.hy_bias[c]));
            }
        }
    }
    xcd_barrier(xb);
    {
        int tid = threadIdx.x; asm volatile("" : "+v"(tid)); const int lane = tid & 63, wv = tid >> 6; (void)lane; (void)wv;
        bf16_t* ts = (bf16_t*)smem;
        for (int u = bid; u < 8 * (MROWS / 64); u += nb) {
            const int cb = u & 7, rb = u >> 3;
            __syncthreads();
            { const int c = tid >> 3, r8 = (tid & 7) * 8; const uint4 v = *(const uint4*)(gT + (size_t)(cb * 64 + c) * MROWS + rb * 64 + r8);
#pragma unroll
              for (int i = 0; i < 8; ++i) ts[c * 66 + r8 + i] = u4e(v, i); }
            __syncthreads();
            { const int r = tid >> 3, c8 = (tid & 7) * 8; uint4 o;
              o.x = (unsigned)ts[(c8 + 0) * 66 + r] | ((unsigned)ts[(c8 + 1) * 66 + r] << 16); o.y = (unsigned)ts[(c8 + 2) * 66 + r] | ((unsigned)ts[(c8 + 3) * 66 + r] << 16);
              o.z = (unsigned)ts[(c8 + 4) * 66 + r] | ((unsigned)ts[(c8 + 5) * 66 + r] << 16); o.w = (unsigned)ts[(c8 + 6) * 66 + r] | ((unsigned)ts[(c8 + 7) * 66 + r] << 16);
              *(uint4*)(ao + (size_t)(rb * 64 + r) * 1024 + cb * 64 + c8) = o; }
        }
    }
    xcd_barrier(xb);
    { EpiRes0 e{p.x, p.ctx, p.out, xc, mod, 2048}; gemm_phase(ao, 1024, Wt + W0_OUT, 1024, MROWS, 1024, 1024, e, smem); }
    xcd_barrier(xb);
    {
        int tid = threadIdx.x; asm volatile("" : "+v"(tid)); const int lane = tid & 63, wv = tid >> 6; (void)lane; (void)wv;
    { RowMap rm{p.out, xc, 0, 0}; normmod_phase(MROWS, rm, p.norm_mlp_g, mod, 3072, 4096, hA, bid * 8 + wv, nb * 8, lane); }
    }
    xcd_barrier(xb);
    { EpiRelu2 e{hid, 4096}; gemm_phase(hA, D, Wt + W0_1, 1024, MROWS, 4096, 1024, e, smem); }
    xcd_barrier(xb);
    { EpiRes0 e{p.out, xc, p.out, xc, mod, 5120}; gemm_phase<true>(hid, 4096, Wt + W0_2, 4096, MROWS, 1024, 4096, e, smem); }
    xcd_barrier(xb);
    const float* mod1 = mod + 3 * 6144;
    for (int u = bid; u < 2048 + 512 + 1024 + 1024; u += nb) {
        if (u < 2048) convert_w(p.od_w_in, Wt + W1_IN, 1024, 8192, u, true, smem);
        else if (u < 2560) convert_w(p.od_w_out, Wt + W1_OUT, 2048, 1024, u - 2048, false, smem);
        else if (u < 3584) convert_w(p.mlp_w1 + (size_t)1024 * 4096, Wt + W1_1, 1024, 4096, u - 2560, false, smem);
        else convert_w(p.mlp_w2 + (size_t)4096 * 1024, Wt + W1_2, 4096, 1024, u - 3584, false, smem);
    }
    bf16_t* q1 = (bf16_t*)(ws + OFF_Q1); bf16_t* kz = (bf16_t*)(ws + OFF_KZ); bf16_t* v1 = (bf16_t*)(ws + OFF_V1);
    bf16_t* inn = (bf16_t*)(ws + OFF_IN); bf16_t* sg = (bf16_t*)(ws + OFF_SG); float* ps = (float*)(ws + OFF_PS);
#pragma unroll 1
    for (int b = 0; b < 2; ++b) {
        int tid = threadIdx.x; asm volatile("" : "+v"(tid));
        const int lane = tid & 63, wv = tid >> 6;
        { RowMap rm{p.out, xc, 1, b}; normmod_phase(RB, rm, p.norm_mix_g + 1024, mod1, 0, 1024, hA, bid * 8 + wv, nb * 8, lane); }
        xcd_barrier(xb);
        { EpiRet e{q1, kz, v1, sg, p.ret_log_rate}; gemm_phase(hA, D, Wt + W1_IN, 1024, RB, 8192, 1024, e, smem); }
        xcd_barrier(xb);
        {
            bf16_t* Ks = (bf16_t*)smem;
            const int fr = lane & 15, fq = lane >> 4;
            for (int u = bid; u < 512; u += nb) {
                const int n = u & 63, h = (u >> 6) & 3, dir = u >> 8;
                const float lg = -__expf(p.ret_log_rate[dir * 4 + h]);
                __syncthreads();
                for (int i = tid; i < 256 * 16; i += NT) {
                    const int dk = i >> 4, t8 = (i & 15) * 8;
                    const uint4 v = *(const uint4*)(kz + ((size_t)dir * 1024 + h * 256 + dk) * RB + n * 128 + t8);
#pragma unroll
                    for (int k = 0; k < 8; ++k) Ks[(t8 + k) * 264 + dk] = u4e(v, k);
                }
                __syncthreads();
                f32x4 acc[8];
#pragma unroll
                for (int i = 0; i < 8; ++i) acc[i] = (f32x4){0.f, 0.f, 0.f, 0.f};
                const bf16_t* qp = q1 + ((size_t)dir * SEQ + n * 128 + wv * 16 + fr) * 1024 + h * 256 + fq * 8;
#pragma unroll
                for (int ks = 0; ks < 8; ++ks) {
                    const bf16x8 af = *(const bf16x8*)(qp + ks * 32);
#pragma unroll
                    for (int nt = 0; nt < 8; ++nt) { const bf16x8 bfv = *(const bf16x8*)(Ks + (nt * 16 + fr) * 264 + ks * 32 + fq * 8); acc[nt] = mfma16(af, bfv, acc[nt]); }
                }
                bf16_t* dst = inn + ((size_t)(dir * 4 + h) * 64 + n) * 16384;
#pragma unroll
                for (int j = 0; j < 4; ++j) {
                    const int a = wv * 16 + fq * 4 + j;
                    const float fac = dir == 0 ? __expf((float)(a - 127) * lg) : __expf(-(float)a * lg);
#pragma unroll
                    for (int nt = 0; nt < 8; ++nt) { const int ap = nt * 16 + fr; const bool ok = dir == 0 ? (a >= ap) : (ap >= a); dst[a * 128 + ap] = f2bf(ok ? acc[nt][j] * fac : 0.f); }
                }
            }
        }
        xcd_barrier(xb);
        {
            bf16_t* Wq = (bf16_t*)(smem + wv * 8192);
            bf16_t* Wi = (bf16_t*)(smem + 65536 + wv * 4096);
            bf16_t* Wg = (bf16_t*)(smem + 98304 + wv * 512);
            bf16_t* Vs = (bf16_t*)(smem + 102400);
            bf16_t* Rl = (bf16_t*)(smem + 110592);
            const int fr = lane & 15, fq = lane >> 4;
            for (int wk0 = bid; wk0 < 256; wk0 += nb) {
                const int wk = (wk0 & 7) * 32 + (wk0 >> 3);
                const int sl = wk & 31, h = (wk >> 5) & 3, dir = wk >> 7;
                const float lg = -__expf(p.ret_log_rate[dir * 4 + h]); const float gC = __expf(128.f * lg);
                const int vcol = h * 512 + sl * 16;
                f32x4 racc0 = (f32x4){0.f, 0.f, 0.f, 0.f}, racc1 = racc0;
                const bf16_t* qg_p = q1 + ((size_t)dir * SEQ + wv * 16 + (lane >> 5)) * 1024 + h * 256 + (lane & 31) * 8;
                const bf16_t* kg_p = kz + ((size_t)dir * 1024 + h * 256 + wv * 32 + (lane >> 4)) * RB + (lane & 15) * 8;
                const bf16_t* ig_p = inn + ((size_t)(dir * 4 + h) * 64) * 16384 + (wv * 16 + (lane >> 4)) * 128 + (lane & 15) * 8;
                const bf16_t* vg_p = v1 + (size_t)(vcol + ((tid >> 4) & 15)) * RB + (tid & 15) * 8;
                bf16_t* gg_p = sg + ((size_t)dir * SEQ + wv * 16 + ((lane >> 1) & 15)) * 2048 + vcol + (lane & 1) * 8;
                float* pg_p = ps + (((size_t)dir * SEQ + wv * 16 + fq * 4) * 4 + h) * 32 + sl;
                bf16_t* qs_d = Wq + (lane >> 5) * 256 + (((lane & 31) ^ (lane >> 5)) * 8);
                bf16_t* ks_d = Wq + (lane >> 4) * 128;
                bf16_t* is_d = Wi + (lane >> 4) * 128;
                bf16_t* vs_d = Vs + ((tid >> 4) & 15) * 128 + (((tid & 15) ^ ((tid >> 4) & 15)) * 8);
                bf16_t* gs_d = Wg + ((lane >> 1) & 15) * 16 + (lane & 1) * 8;
                (void)qs_d;
                float xi[4];
#pragma unroll
                for (int j = 0; j < 4; ++j) { const int a = wv * 16 + fq * 4 + j; xi[j] = dir == 0 ? __expf((float)(a + 1) * lg) : __expf((float)(128 - a) * lg); }
#define SC_ROW(st) ((st) < 2 ? SEQ + (dir == 0 ? (st) : 1 - (st)) * 128 : (dir == 0 ? (st) - 2 : 65 - (st)) * 128)
                uint4 qg0, qg1, qg2, qg3, qg4, qg5, qg6, qg7, kg0, kg1, kg2, kg3, kg4, kg5, kg6, kg7, ig0, ig1, ig2, ig3, vg, gg;
                qg0 = qg1 = qg2 = qg3 = qg4 = qg5 = qg6 = qg7 = make_uint4(0, 0, 0, 0); ig0 = ig1 = ig2 = ig3 = qg0; gg = qg0; vg = qg0;
#define SC_LDK(r0) { const bf16_t* kp_ = kg_p + (r0); kg0 = *(const uint4*)(kp_); kg1 = *(const uint4*)(kp_ + (size_t)4 * RB); kg2 = *(const uint4*)(kp_ + (size_t)8 * RB); kg3 = *(const uint4*)(kp_ + (size_t)12 * RB); \
    kg4 = *(const uint4*)(kp_ + (size_t)16 * RB); kg5 = *(const uint4*)(kp_ + (size_t)20 * RB); kg6 = *(const uint4*)(kp_ + (size_t)24 * RB); kg7 = *(const uint4*)(kp_ + (size_t)28 * RB); }
#define SC_LDQ(r0) { const bf16_t* qp_ = qg_p + (size_t)(r0) * 1024; qg0 = *(const uint4*)(qp_); qg1 = *(const uint4*)(qp_ + 2 * 1024); qg2 = *(const uint4*)(qp_ + 4 * 1024); qg3 = *(const uint4*)(qp_ + 6 * 1024); \
    qg4 = *(const uint4*)(qp_ + 8 * 1024); qg5 = *(const uint4*)(qp_ + 10 * 1024); qg6 = *(const uint4*)(qp_ + 12 * 1024); qg7 = *(const uint4*)(qp_ + 14 * 1024); \
    const bf16_t* ip_ = ig_p + (size_t)((r0) >> 7) * 16384; ig0 = *(const uint4*)(ip_); ig1 = *(const uint4*)(ip_ + 4 * 128); ig2 = *(const uint4*)(ip_ + 8 * 128); ig3 = *(const uint4*)(ip_ + 12 * 128); \
    if (lane < 32) gg = *(const uint4*)(gg_p + (size_t)(r0) * 2048); }
#define SC_STQ(i, v) { const int row_ = 2 * (i) + (lane >> 5); *(uint4*)(Wq + row_ * 256 + (((lane & 31) ^ row_) * 8)) = (v); }
#define SC_STK(i, v) { const int row_ = 4 * (i) + (lane >> 4); *(uint4*)(ks_d + 4 * (i) * 128 + (((lane & 15) ^ (row_ & 15)) * 8)) = (v); }
#define SC_STI(i, v) { const int row_ = 4 * (i) + (lane >> 4); *(uint4*)(is_d + 4 * (i) * 128 + (((lane & 15) ^ (row_ & 15)) * 8)) = (v); }
                SC_LDK(SC_ROW(0))
                if (tid < 256) vg = *(const uint4*)(vg_p + SC_ROW(0));
#pragma unroll 2
                for (int st = 0; st < 66; ++st) {
                    const bool lat = st >= 2; const int row0 = SC_ROW(st); const int nrow = SC_ROW(st + 1);
                    const bool hasn = st + 1 < 66; const bool nlat = st + 1 >= 2 && hasn;
                    bf16_t* vsb = Vs + (st & 1) * 2048;
                    if (lat) {
                        SC_STQ(0, qg0) SC_STQ(1, qg1) SC_STQ(2, qg2) SC_STQ(3, qg3) SC_STQ(4, qg4) SC_STQ(5, qg5) SC_STQ(6, qg6) SC_STQ(7, qg7)
                        SC_STI(0, ig0) SC_STI(1, ig1) SC_STI(2, ig2) SC_STI(3, ig3)
                        if (lane < 32) *(uint4*)(gs_d) = gg;
                        bf16_t* rw = Rl + (st & 1) * 16 * 264 + fr * 264 + wv * 32 + fq * 4;
                        uint2 t; t.x = pk2(racc0[0], racc0[1]); t.y = pk2(racc0[2], racc0[3]); *(uint2*)(rw) = t;
                        t.x = pk2(racc1[0], racc1[1]); t.y = pk2(racc1[2], racc1[3]); *(uint2*)(rw + 16) = t;
                    }
                    if (tid < 256) *(uint4*)(vs_d + (st & 1) * 2048) = vg;
                    if (nlat) SC_LDQ(nrow)
                    if (hasn && tid < 256) vg = *(const uint4*)(vg_p + nrow);
                    __syncthreads();
                    const bf16x8 vf0 = *(const bf16x8*)(vsb + fr * 128 + (((0 + fq) ^ fr) * 8)), vf1 = *(const bf16x8*)(vsb + fr * 128 + (((4 + fq) ^ fr) * 8));
                    const bf16x8 vf2 = *(const bf16x8*)(vsb + fr * 128 + (((8 + fq) ^ fr) * 8)), vf3 = *(const bf16x8*)(vsb + fr * 128 + (((12 + fq) ^ fr) * 8));
                    if (lat) {
                        f32x4 oq = (f32x4){0.f, 0.f, 0.f, 0.f}, oq2 = oq, oi = oq;
                        const bf16_t* qrow = Wq + fr * 256; const bf16_t* irow = Wi + fr * 128;
                        const bf16_t* rl = Rl + (st & 1) * 16 * 264 + fr * 264 + fq * 8;
#pragma unroll
                        for (int ks = 0; ks < 8; ks += 2) {
                            oq = mfma16(*(const bf16x8*)(qrow + (((ks * 4 + fq) ^ fr) * 8)), *(const bf16x8*)(rl + ks * 32), oq);
                            oq2 = mfma16(*(const bf16x8*)(qrow + ((((ks + 1) * 4 + fq) ^ fr) * 8)), *(const bf16x8*)(rl + (ks + 1) * 32), oq2);
                        }
                        oi = mfma16(*(const bf16x8*)(irow + (((0 + fq) ^ fr) * 8)), vf0, oi); oi = mfma16(*(const bf16x8*)(irow + (((4 + fq) ^ fr) * 8)), vf1, oi);
                        oi = mfma16(*(const bf16x8*)(irow + (((8 + fq) ^ fr) * 8)), vf2, oi); oi = mfma16(*(const bf16x8*)(irow + (((12 + fq) ^ fr) * 8)), vf3, oi);
                        float ov[4];
#pragma unroll
                        for (int j = 0; j < 4; ++j) ov[j] = oi[j] + xi[j] * (oq[j] + oq2[j]);
                        const float q0_ = row16_sum(ov[0] * ov[0]), q1_ = row16_sum(ov[1] * ov[1]), q2_ = row16_sum(ov[2] * ov[2]), q3_ = row16_sum(ov[3] * ov[3]);
                        if (fr == 0) { float* pp = pg_p + (size_t)row0 * 128; pp[0] = q0_; pp[128] = q1_; pp[256] = q2_; pp[384] = q3_; }
                        bf16_t* gp_ = Wg + (fq * 4) * 16 + fr;
#pragma unroll
                        for (int j = 0; j < 4; ++j) gp_[j * 16] = f2bf(bf2f(gp_[j * 16]) * ov[j]);
                        if (lane < 32) *(uint4*)(gg_p + (size_t)row0 * 2048) = *(const uint4*)(gs_d);
                    }
                    SC_STK(0, kg0) SC_STK(1, kg1) SC_STK(2, kg2) SC_STK(3, kg3) SC_STK(4, kg4) SC_STK(5, kg5) SC_STK(6, kg6) SC_STK(7, kg7)
                    if (hasn) SC_LDK(nrow)
                    racc0 = racc0 * gC; racc1 = racc1 * gC;
                    {
                        const bf16_t* k0 = Wq + fr * 128; const bf16_t* k1 = k0 + 16 * 128;
                        racc0 = mfma16(*(const bf16x8*)(k0 + (((0 + fq) ^ fr) * 8)), vf0, racc0); racc1 = mfma16(*(const bf16x8*)(k1 + (((0 + fq) ^ fr) * 8)), vf0, racc1);
                        racc0 = mfma16(*(const bf16x8*)(k0 + (((4 + fq) ^ fr) * 8)), vf1, racc0); racc1 = mfma16(*(const bf16x8*)(k1 + (((4 + fq) ^ fr) * 8)), vf1, racc1);
                        racc0 = mfma16(*(const bf16x8*)(k0 + (((8 + fq) ^ fr) * 8)), vf2, racc0); racc1 = mfma16(*(const bf16x8*)(k1 + (((8 + fq) ^ fr) * 8)), vf2, racc1);
                        racc0 = mfma16(*(const bf16x8*)(k0 + (((12 + fq) ^ fr) * 8)), vf3, racc0); racc1 = mfma16(*(const bf16x8*)(k1 + (((12 + fq) ^ fr) * 8)), vf3, racc1);
                    }
                }
                __syncthreads();
            }
        }
        xcd_barrier(xb);
        for (int u = bid; u < SEQ / 8; u += nb) {
            const int r = u * 8 + wv;
            float rv[4];
#pragma unroll
            for (int i = 0; i < 4; ++i) {
                const int dir = i >> 1, hh = (i & 1) * 2 + (lane >> 5), s = lane & 31;
                float v = ps[(((size_t)dir * SEQ + r) * 4 + hh) * 32 + s];
                v += __shfl_xor(v, 1); v += __shfl_xor(v, 2); v += __shfl_xor(v, 4); v += __shfl_xor(v, 8); v += __shfl_xor(v, 16);
                rv[i] = rsqrtf(v * (1.f / 512.f) + 1e-6f);
            }
            bf16_t* pf = sg + (size_t)r * 2048 + lane * 4; const bf16_t* pb = pf + (size_t)SEQ * 2048;
            uint2 la[8], lb[8];
#pragma unroll
            for (int it = 0; it < 8; ++it) { la[it] = *(const uint2*)(pf + it * 256); lb[it] = *(const uint2*)(pb + it * 256); }
#pragma unroll
            for (int it = 0; it < 8; ++it) {
                const int hh = it >> 1;
                const float rf = __shfl(rv[hh >> 1], (hh & 1) * 32), rbk = __shfl(rv[2 + (hh >> 1)], (hh & 1) * 32);
                const uint2 a = la[it], bq = lb[it];
                uint2 o; o.x = pk2(bf2f(u2e(a, 0)) * rf + bf2f(u2e(bq, 0)) * rbk, bf2f(u2e(a, 1)) * rf + bf2f(u2e(bq, 1)) * rbk); o.y = pk2(bf2f(u2e(a, 2)) * rf + bf2f(u2e(bq, 2)) * rbk, bf2f(u2e(a, 3)) * rf + bf2f(u2e(bq, 3)) * rbk);
                *(uint2*)(pf + it * 256) = o;
            }
        }
        xcd_barrier(xb);
        { EpiResLat e{p.out, mod1, 2048, b * SEQ}; gemm_phase(sg, 2048, Wt + W1_OUT, 2048, SEQ, 1024, 2048, e, smem); }
        xcd_barrier(xb);
    }
    int tid2 = threadIdx.x; asm volatile("" : "+v"(tid2));
    const int lane2 = tid2 & 63, wv2 = tid2 >> 6;
    { RowMap rm{p.out, xc, 2, 0}; normmod_phase(16384, rm, p.norm_mlp_g + 1024, mod1, 3072, 4096, hA, bid * 8 + wv2, nb * 8, lane2); }
    xcd_barrier(xb);
    { EpiRelu2 e{hid, 4096}; gemm_phase(hA, D, Wt + W1_1, 1024, 16384, 4096, 1024, e, smem); }
    xcd_barrier(xb);
    { EpiResLat e{p.out, mod1, 5120, 0}; gemm_phase(hid, 4096, Wt + W1_2, 4096, 16384, 1024, 4096, e, smem); }
    xcd_barrier(xb);
    for (int u = bid; u < 16384 / 8; u += nb) {
        const int r = u * 8 + wv2; float* row = p.out + (size_t)r * D;
        float4 v[4]; float ss = 0.f;
#pragma unroll
        for (int i = 0; i < 4; ++i) { v[i] = *(const float4*)(row + i * 256 + lane2 * 4); ss += v[i].x * v[i].x + v[i].y * v[i].y + v[i].z * v[i].z + v[i].w * v[i].w; }
#pragma unroll
        for (int o = 32; o >= 1; o >>= 1) ss += __shfl_xor(ss, o);
        const float rsd = rsqrtf(ss * (1.f / 1024.f) + 1e-6f);
#pragma unroll
        for (int i = 0; i < 4; ++i) { const float4 gg = *(const float4*)(p.final_g + i * 256 + lane2 * 4); *(float4*)(row + i * 256 + lane2 * 4) = make_float4(v[i].x * rsd * gg.x, v[i].y * rsd * gg.y, v[i].z * rsd * gg.z, v[i].w * rsd * gg.w); }
    }
}

extern "C" void kernel_launch(void* const* d_in, const int* in_sizes, int n_in, void* d_out, int out_size, void* d_ws, size_t ws_size, hipStream_t stream) {
    static int grid_blocks = 0;
    if (!grid_blocks) {
        int dev = 0, cus = 0, per_cu = 0;
        hipGetDevice(&dev);
        hipDeviceGetAttribute(&cus, hipDeviceAttributeMultiprocessorCount, dev);
        hipFuncSetAttribute((const void*)fwd_megakernel, hipFuncAttributeMaxDynamicSharedMemorySize, LDS_BYTES);
        hipOccupancyMaxActiveBlocksPerMultiprocessor(&per_cu, (const void*)fwd_megakernel, NT, LDS_BYTES);
        if (per_cu < 1) per_cu = 1;
        grid_blocks = (cus * per_cu) & ~7;
        if (ws_size < 256 * MiB) fprintf(stderr, "workspace too small: %zu\n", ws_size);
    }
    Params p{};
    const float** pp = (const float**)&p;
    for (int i = 0; i < 27; ++i) pp[i] = (const float*)d_in[i];
    p.out = (float*)d_out; p.ws = (unsigned char*)d_ws;
    (void)hipMemsetAsync((unsigned char*)d_ws + OFF_BAR, 0, XCD_BAR_WORDS * 4, stream);
    void* args[] = {&p};
    hipError_t e = hipLaunchCooperativeKernel((void*)fwd_megakernel, dim3(grid_blocks), dim3(NT), args, LDS_BYTES, stream);
    if (e != hipSuccess) fprintf(stderr, "cooperative launch failed: %s (grid %d)\n", hipGetErrorString(e), grid_blocks);
}
```

```cpp
#include <hip/hip_runtime.h>
#include <hip/hip_cooperative_groups.h>
#include <cstdio>
#include <cstdint>
namespace cg = cooperative_groups;

typedef unsigned short bf16_t;
typedef short bf16x8 __attribute__((ext_vector_type(8)));
typedef short bf16x4 __attribute__((ext_vector_type(4)));
typedef float f32x4 __attribute__((ext_vector_type(4)));

#define NT 512
constexpr int D = 1024, SEQ = 8192, CTXL = 256, RB = 8448, MROWS = 16896;
constexpr int LDS_BYTES = 139264;
constexpr size_t MiB = 1048576;
constexpr size_t OFF_MOD = 0;
constexpr size_t OFF_BAR = 512 * 1024;
constexpr size_t OFF_TW = 1 * MiB;
constexpr size_t OFF_XC = 2 * MiB;
constexpr size_t OFF_WT = 4 * MiB;
constexpr size_t OFF_HA = 40 * MiB;
constexpr size_t OFF_HT = 73 * MiB;
constexpr size_t OFF_HTC = 105 * MiB;
constexpr size_t OFF_PN = 106 * MiB;
constexpr size_t OFF_HF = 108 * MiB;
constexpr size_t OFF_U = 172 * MiB;
constexpr size_t OFF_QR = 222 * MiB;
constexpr size_t OFF_KR = 239 * MiB;
constexpr size_t OFF_VT = 244 * MiB;
constexpr size_t OFF_GT = 73 * MiB;
constexpr size_t OFF_AO = 172 * MiB;
constexpr size_t OFF_HID = 73 * MiB;
constexpr size_t DO_ZT = 0, DO_X0T = 33 * MiB;
constexpr size_t OFF_Q1 = 57 * MiB;
constexpr size_t OFF_KZ = 89 * MiB;
constexpr size_t OFF_V1 = 122 * MiB;
constexpr size_t OFF_IN = 155 * MiB;
constexpr size_t OFF_SG = 171 * MiB;
constexpr size_t OFF_PS = 235 * MiB;
constexpr size_t W0_IN = 0, W0_OUT = W0_IN + 2304 * 1024, W0_1 = W0_OUT + 1024 * 1024, W0_2 = W0_1 + 4096 * 1024;
constexpr size_t W1_IN = 0, W1_OUT = W1_IN + 8192 * 1024, W1_1 = W1_OUT + 1024 * 2048, W1_2 = W1_1 + 4096 * 1024;

struct Params {
    const float *x, *c, *ctx, *c_ctx, *ada_w, *ada_b, *norm_mix_g, *norm_mlp_g, *mlp_w1, *mlp_w2, *ev_w_in, *ev_w_out, *hy_conv_w, *hy_conv_b,
        *hy_w1, *hy_b1, *hy_w2, *hy_b2, *hy_w3, *hy_freq, *hy_decay, *hy_bias, *attn_sink, *od_w_in, *od_w_out, *ret_log_rate, *final_g;
    float* out; unsigned char* ws;
};

__device__ __forceinline__ bf16_t f2bf(float f) { unsigned u = __float_as_uint(f); u += 0x7fffu + ((u >> 16) & 1u); return (bf16_t)(u >> 16); }
__device__ __forceinline__ float bf2f(bf16_t h) { return __uint_as_float(((unsigned)h) << 16); }
__device__ __forceinline__ unsigned pk2(float a, float b) { return (unsigned)f2bf(a) | ((unsigned)f2bf(b) << 16); }
__device__ __forceinline__ bf16_t u4e(const uint4& v, int i) { const unsigned w = (i >> 1) == 0 ? v.x : (i >> 1) == 1 ? v.y : (i >> 1) == 2 ? v.z : v.w; return (bf16_t)((i & 1) ? (w >> 16) : (w & 0xffffu)); }
__device__ __forceinline__ bf16_t u2e(const uint2& v, int i) { const unsigned w = (i >> 1) == 0 ? v.x : v.y; return (bf16_t)((i & 1) ? (w >> 16) : (w & 0xffffu)); }
#define DPP_ADD(v, ctrl) ((v) + __builtin_bit_cast(float, __builtin_amdgcn_update_dpp(0, __builtin_bit_cast(int, (v)), (ctrl), 0xF, 0xF, true)))
__device__ __forceinline__ float row16_sum(float v) { v = DPP_ADD(v, 0xB1); v = DPP_ADD(v, 0x4E); v = DPP_ADD(v, 0x141); v = DPP_ADD(v, 0x140); return v; }
__device__ __forceinline__ float siluf(float v) { return v * __builtin_amdgcn_rcpf(1.f + __expf(-v)); }
__device__ __forceinline__ void fast_sincos(float x, float& s, float& c) {
    float k = rintf(x * 0.15915494309189535f);
    float r = fmaf(-k, 6.28125f, x); r = fmaf(-k, 1.9353071795864769e-3f, r);
    s = __sinf(r); c = __cosf(r);
}
__device__ __forceinline__ float2 cmul(float2 a, float2 b) { return make_float2(a.x * b.x - a.y * b.y, a.x * b.y + a.y * b.x); }
__device__ __forceinline__ float2 cadd(float2 a, float2 b) { return make_float2(a.x + b.x, a.y + b.y); }
__device__ __forceinline__ float2 csub(float2 a, float2 b) { return make_float2(a.x - b.x, a.y - b.y); }
__device__ __forceinline__ f32x4 mfma16(bf16x8 a, bf16x8 b, f32x4 c) { return __builtin_amdgcn_mfma_f32_16x16x32_bf16(a, b, c, 0, 0, 0); }

template <bool SPLIT = false, class Epi>
__device__ __forceinline__ void gemm_phase(const bf16_t* __restrict__ A, int lda, const bf16_t* __restrict__ Bt, int ldb, int M, int N, int K, const Epi& epi, unsigned char* smem) {
    int tid = threadIdx.x; asm volatile("" : "+v"(tid));
    const int lane = tid & 63, w = tid >> 6, wm = w >> 1, wn = w & 1;
    const int nN = N / 128, ntiles = (M / 256) * nN, nk = K / 64;
    bf16_t* As = (bf16_t*)smem;
    bf16_t* Bs = As + 2 * 256 * 64;
    const int lr = tid >> 3, lc = (tid & 7) * 8;
    const int fr = lane & 15, fq = lane >> 4;
    const int xcd_ = blockIdx.x & 7, jl_ = blockIdx.x >> 3, nbl_ = gridDim.x >> 3;
    const int tbeg_ = (int)(((long)ntiles * xcd_) >> 3), tend_ = (int)(((long)ntiles * (xcd_ + 1)) >> 3);
    const int len_ = tend_ - tbeg_; const int full_ = SPLIT ? (len_ / nbl_) * nbl_ : len_; const int tail_ = len_ - full_;
    int parts_ = 1;
    if (SPLIT && tail_ > 0) { const int lim = (nbl_ / tail_) < (nk >> 1) ? (nbl_ / tail_) : (nk >> 1); while (parts_ * 2 <= lim) parts_ *= 2; }
#define G_ITEM(IT, TILE, KB, NKK, ATOM, OK) { OK = true; KB = 0; NKK = nk; ATOM = false; TILE = 0; \
        if ((IT) < full_) TILE = tbeg_ + (IT); \
        else if (SPLIT && parts_ > 1 && (IT) - full_ < tail_ * parts_) { const int e_ = (IT) - full_; TILE = tbeg_ + full_ + e_ / parts_; NKK = nk / parts_; KB = (e_ % parts_) * NKK; ATOM = true; } \
        else if ((IT) < len_ && parts_ == 1) TILE = tbeg_ + (IT); \
        else OK = false; }
    uint4 pa0, pa1, pa2, pa3, pb0, pb1;
    uint4 qa0, qa1, qa2, qa3, qb0, qb1;
    bool primed_ = false;
    for (int it = jl_; ; it += nbl_) {
        int tile, kb_, nkk; bool atom_, ok_;
        G_ITEM(it, tile, kb_, nkk, atom_, ok_)
        if (!ok_) break;
        const int tm = tile / nN, tn = tile % nN;
        const bf16_t* Ag = A + (size_t)(tm * 256 + lr) * lda + lc + kb_ * 64;
        const bf16_t* Bg = Bt + (size_t)(tn * 128 + lr) * ldb + lc + kb_ * 64;
        int ntile_, nkb_, nnkk_; bool natom_, nok_;
        G_ITEM(it + nbl_, ntile_, nkb_, nnkk_, natom_, nok_)
        (void)natom_; (void)nnkk_;
        const bf16_t* Agn = A + (size_t)((ntile_ / nN) * 256 + lr) * lda + lc + nkb_ * 64;
        const bf16_t* Bgn = Bt + (size_t)((ntile_ % nN) * 128 + lr) * ldb + lc + nkb_ * 64;
        f32x4 acc[4][4];
#pragma unroll
        for (int i = 0; i < 4; ++i)
#pragma unroll
            for (int j = 0; j < 4; ++j) acc[i][j] = (f32x4){0.f, 0.f, 0.f, 0.f};
#define G_LOADN(P, kt_) { const bf16_t* ag = Agn + (kt_) * 64; const bf16_t* bg = Bgn + (kt_) * 64; \
    P##a0 = *(const uint4*)(ag); P##a1 = *(const uint4*)(ag + (size_t)64 * lda); P##a2 = *(const uint4*)(ag + (size_t)128 * lda); P##a3 = *(const uint4*)(ag + (size_t)192 * lda); \
    P##b0 = *(const uint4*)(bg); P##b1 = *(const uint4*)(bg + (size_t)64 * ldb); }
#define G_LOAD(P, kt_) { const bf16_t* ag = Ag + (kt_) * 64; const bf16_t* bg = Bg + (kt_) * 64; \
    P##a0 = *(const uint4*)(ag); P##a1 = *(const uint4*)(ag + (size_t)64 * lda); P##a2 = *(const uint4*)(ag + (size_t)128 * lda); P##a3 = *(const uint4*)(ag + (size_t)192 * lda); \
    P##b0 = *(const uint4*)(bg); P##b1 = *(const uint4*)(bg + (size_t)64 * ldb); }
#define G_STORE(P, buf_) { const int lcs = ((tid & 7) ^ ((tid >> 4) & 7)) * 8; bf16_t* ad = As + (buf_) * 256 * 64 + lr * 64 + lcs; bf16_t* bd = Bs + (buf_) * 128 * 64 + lr * 64 + lcs; \
    *(uint4*)(ad) = P##a0; *(uint4*)(ad + 64 * 64) = P##a1; *(uint4*)(ad + 128 * 64) = P##a2; *(uint4*)(ad + 192 * 64) = P##a3; \
    *(uint4*)(bd) = P##b0; *(uint4*)(bd + 64 * 64) = P##b1; }
#define G_MFMA16(a0, a1, a2, a3, b0, b1, b2, b3) { __builtin_amdgcn_s_setprio(1); \
        acc[0][0] = mfma16(a0, b0, acc[0][0]); acc[0][1] = mfma16(a0, b1, acc[0][1]); acc[0][2] = mfma16(a0, b2, acc[0][2]); acc[0][3] = mfma16(a0, b3, acc[0][3]); \
        acc[1][0] = mfma16(a1, b0, acc[1][0]); acc[1][1] = mfma16(a1, b1, acc[1][1]); acc[1][2] = mfma16(a1, b2, acc[1][2]); acc[1][3] = mfma16(a1, b3, acc[1][3]); \
        acc[2][0] = mfma16(a2, b0, acc[2][0]); acc[2][1] = mfma16(a2, b1, acc[2][1]); acc[2][2] = mfma16(a2, b2, acc[2][2]); acc[2][3] = mfma16(a2, b3, acc[2][3]); \
        acc[3][0] = mfma16(a3, b0, acc[3][0]); acc[3][1] = mfma16(a3, b1, acc[3][1]); acc[3][2] = mfma16(a3, b2, acc[3][2]); acc[3][3] = mfma16(a3, b3, acc[3][3]); \
        __builtin_amdgcn_s_setprio(0); }
#define G_PRE(buf_) \
    const bf16_t* as_ = As + (buf_) * 256 * 64 + (wm * 64 + fr) * 64; const bf16_t* bs_ = Bs + (buf_) * 128 * 64 + (wn * 64 + fr) * 64; \
    const int so0_ = ((fq) ^ (fr >> 1)) << 3, so1_ = ((4 | fq) ^ (fr >> 1)) << 3; \
    const bf16x8 fa0 = *(const bf16x8*)(as_ + so0_), fa1 = *(const bf16x8*)(as_ + 16 * 64 + so0_), fa2 = *(const bf16x8*)(as_ + 32 * 64 + so0_), fa3 = *(const bf16x8*)(as_ + 48 * 64 + so0_); \
    const bf16x8 fb0 = *(const bf16x8*)(bs_ + so0_), fb1 = *(const bf16x8*)(bs_ + 16 * 64 + so0_), fb2 = *(const bf16x8*)(bs_ + 32 * 64 + so0_), fb3 = *(const bf16x8*)(bs_ + 48 * 64 + so0_);
#define G_MID() G_MFMA16(fa0, fa1, fa2, fa3, fb0, fb1, fb2, fb3)
#define G_RD1() \
    const bf16x8 ga0 = *(const bf16x8*)(as_ + so1_), ga1 = *(const bf16x8*)(as_ + 16 * 64 + so1_), ga2 = *(const bf16x8*)(as_ + 32 * 64 + so1_), ga3 = *(const bf16x8*)(as_ + 48 * 64 + so1_); \
    const bf16x8 gb0 = *(const bf16x8*)(bs_ + so1_), gb1 = *(const bf16x8*)(bs_ + 16 * 64 + so1_), gb2 = *(const bf16x8*)(bs_ + 32 * 64 + so1_), gb3 = *(const bf16x8*)(bs_ + 48 * 64 + so1_);
#define G_POST() G_MFMA16(ga0, ga1, ga2, ga3, gb0, gb1, gb2, gb3)
        if (!primed_) { G_LOAD(p, 0) G_LOAD(q, 1) }
        __syncthreads();
        G_STORE(p, 0)
        if (2 < nkk) G_LOAD(p, 2) else if (nok_) G_LOADN(p, 0)
        for (int kt = 0; kt < nkk; kt += 2) {
            __syncthreads();
            {
                G_PRE(0)
                G_MID()
                G_RD1()
                G_STORE(q, 1)
                if (kt + 3 < nkk) G_LOAD(q, kt + 3) else if (nok_) G_LOADN(q, 1)
                G_POST()
            }
            __syncthreads();
            {
                G_PRE(1)
                G_MID()
                G_RD1()
                if (kt + 2 < nkk) { G_STORE(p, 0) if (kt + 4 < nkk) G_LOAD(p, kt + 4) else if (nok_) G_LOADN(p, 0) }
                G_POST()
            }
        }
        primed_ = nok_;
        { int ln = lane; asm volatile("" : "+v"(ln));
          if constexpr (SPLIT) { if (atom_) epi.atom(acc, tm * 256 + wm * 64, tn * 128 + wn * 64, ln); else epi(acc, tm * 256 + wm * 64, tn * 128 + wn * 64, ln); }
          else epi(acc, tm * 256 + wm * 64, tn * 128 + wn * 64, ln); }
    }
}

__device__ __forceinline__ void epi_store_cols_bf16(f32x4 (&acc)[4][4], bf16_t* __restrict__ dstT, size_t ldT, int lane) {
    extern __shared__ __attribute__((aligned(16))) unsigned char smem_e[];
    bf16_t* st = (bf16_t*)(smem_e + 98304 + (threadIdx.x >> 6) * 4608);
    const int fr = lane & 15, fq = lane >> 4;
#pragma unroll
    for (int half = 0; half < 2; ++half) {
#pragma unroll
        for (int n2 = 0; n2 < 2; ++n2)
#pragma unroll
            for (int mt = 0; mt < 4; ++mt) { const f32x4 a = acc[mt][half * 2 + n2]; uint2 pk; pk.x = pk2(a[0], a[1]); pk.y = pk2(a[2], a[3]); *(uint2*)(st + (n2 * 16 + fr) * 72 + mt * 16 + fq * 4) = pk; }
#pragma unroll
        for (int i = 0; i < 4; ++i) { const int pc = lane + 64 * i; const int c = pc >> 3, ch = pc & 7;
            *(uint4*)(dstT + (size_t)(half * 32 + c) * ldT + ch * 8) = *(const uint4*)(st + c * 72 + ch * 8); }
    }
}

struct EpiWin {
    bf16_t *u, *qr, *kr, *vT;
    __device__ __forceinline__ void operator()(f32x4 (&acc)[4][4], int row0, int col0, int lane) const {
        const int fr = lane & 15, fq = lane >> 4;
        if (col0 < 1536) {
#pragma unroll
            for (int mt = 0; mt < 4; ++mt)
#pragma unroll
                for (int nt = 0; nt < 4; ++nt)
#pragma unroll
                    for (int j = 0; j < 4; ++j) u[(size_t)(row0 + mt * 16 + fq * 4 + j) * 1536 + col0 + nt * 16 + fr] = f2bf(acc[mt][nt][j]);
        } else if (col0 < 2176) {
            const bool isq = col0 < 2048;
            const int hc = isq ? (col0 - 1536) : (col0 - 2048);
            bf16_t* dst = isq ? qr : kr; const int ld = isq ? 512 : 128; const float sc = isq ? 0.125f : 1.f;
            const float inv = exp2f(-(float)fr * (13.287712379549449f / 16.f));
#pragma unroll
            for (int mt = 0; mt < 4; ++mt)
#pragma unroll
                for (int j = 0; j < 4; ++j) {
                    const int row = row0 + mt * 16 + fq * 4 + j; const int s = row % RB;
                    float v0 = acc[mt][0][j], v1 = acc[mt][1][j], v2 = acc[mt][2][j], v3 = acc[mt][3][j];
                    if (s < SEQ) {
                        float sr, cr, sc2, cc; fast_sincos((float)(s >> 6) * inv, sr, cr); fast_sincos((float)(s & 63) * inv, sc2, cc);
                        const float a0 = v0 * cr - v1 * sr, a1 = v1 * cr + v0 * sr, a2 = v2 * cc - v3 * sc2, a3 = v3 * cc + v2 * sc2;
                        v0 = a0; v1 = a1; v2 = a2; v3 = a3;
                    }
                    bf16_t* o = dst + (size_t)row * ld + hc + fr;
                    o[0] = f2bf(v0 * sc); o[16] = f2bf(v1 * sc); o[32] = f2bf(v2 * sc); o[48] = f2bf(v3 * sc);
                }
        } else {
            const int hc = col0 - 2176;
            epi_store_cols_bf16(acc, vT + (size_t)hc * MROWS + row0, (size_t)MROWS, lane);
        }
    }
};
struct EpiRes0 {
    const float *srcl, *srcc; float *dstl, *dstc; const float* mod; int goff;
    __device__ __forceinline__ void operator()(f32x4 (&acc)[4][4], int row0, int col0, int lane) const {
        const int fr = lane & 15, fq = lane >> 4;
        const int b = row0 / RB; const int i0 = row0 % RB; const bool lat = i0 < SEQ;
        const float* g = mod + (lat ? b : 2) * 6144 + goff;
        float gv[4];
#pragma unroll
        for (int nt = 0; nt < 4; ++nt) gv[nt] = g[col0 + nt * 16 + fr];
        const size_t base0 = lat ? ((size_t)(b * SEQ + i0 + fq * 4) * D) : ((size_t)(b * CTXL + i0 - SEQ + fq * 4) * D);
        const float* s0 = (lat ? srcl : srcc) + base0 + col0 + fr; float* d0 = (lat ? dstl : dstc) + base0 + col0 + fr;
#pragma unroll
        for (int mt = 0; mt < 4; ++mt) {
            float sv[4][4];
#pragma unroll
            for (int j = 0; j < 4; ++j)
#pragma unroll
                for (int nt = 0; nt < 4; ++nt) sv[j][nt] = s0[(size_t)(mt * 16 + j) * D + nt * 16];
#pragma unroll
            for (int j = 0; j < 4; ++j)
#pragma unroll
                for (int nt = 0; nt < 4; ++nt) d0[(size_t)(mt * 16 + j) * D + nt * 16] = sv[j][nt] + gv[nt] * acc[mt][nt][j];
        }
    }
    __device__ __forceinline__ void atom(f32x4 (&acc)[4][4], int row0, int col0, int lane) const {
        const int fr = lane & 15, fq = lane >> 4;
        const int b = row0 / RB; const int i0 = row0 % RB; const bool lat = i0 < SEQ;
        const float* g = mod + (lat ? b : 2) * 6144 + goff;
#pragma unroll
        for (int mt = 0; mt < 4; ++mt)
#pragma unroll
            for (int j = 0; j < 4; ++j) {
                const int i = i0 + mt * 16 + fq * 4 + j;
                const size_t base = lat ? ((size_t)(b * SEQ + i) * D) : ((size_t)(b * CTXL + i - SEQ) * D);
                float* d = (lat ? dstl : dstc) + base;
#pragma unroll
                for (int nt = 0; nt < 4; ++nt) { const int col = col0 + nt * 16 + fr; atomicAdd(&d[col], g[col] * acc[mt][nt][j]); }
            }
    }
};
struct EpiRelu2 {
    bf16_t* h; int ld;
    __device__ __forceinline__ void operator()(f32x4 (&acc)[4][4], int row0, int col0, int lane) const {
        const int fr = lane & 15, fq = lane >> 4;
#pragma unroll
        for (int mt = 0; mt < 4; ++mt)
#pragma unroll
            for (int nt = 0; nt < 4; ++nt)
#pragma unroll
                for (int j = 0; j < 4; ++j) { float v = fmaxf(acc[mt][nt][j], 0.f); h[(size_t)(row0 + mt * 16 + fq * 4 + j) * ld + col0 + nt * 16 + fr] = f2bf(v * v); }
    }
};
struct EpiResLat {
    float* dst; const float* mod; int goff; int rowoff;
    __device__ __forceinline__ void operator()(f32x4 (&acc)[4][4], int row0, int col0, int lane) const {
        const int fr = lane & 15, fq = lane >> 4;
        const int r0 = row0 + rowoff; const float* g = mod + (r0 / SEQ) * 6144 + goff;
        float gv[4];
#pragma unroll
        for (int nt = 0; nt < 4; ++nt) gv[nt] = g[col0 + nt * 16 + fr];
        float* d0 = dst + (size_t)(r0 + fq * 4) * D + col0 + fr;
#pragma unroll
        for (int mt = 0; mt < 4; ++mt) {
            float sv[4][4];
#pragma unroll
            for (int j = 0; j < 4; ++j)
#pragma unroll
                for (int nt = 0; nt < 4; ++nt) sv[j][nt] = d0[(size_t)(mt * 16 + j) * D + nt * 16];
#pragma unroll
            for (int j = 0; j < 4; ++j)
#pragma unroll
                for (int nt = 0; nt < 4; ++nt) d0[(size_t)(mt * 16 + j) * D + nt * 16] = sv[j][nt] + gv[nt] * acc[mt][nt][j];
        }
    }
};
struct EpiRet {
    bf16_t *q1, *kz, *v1, *sg; const float* lrate;
    __device__ __forceinline__ void operator()(f32x4 (&acc)[4][4], int row0, int col0, int lane) const {
        const int fr = lane & 15, fq = lane >> 4;
        if (col0 < 2048) {
            const bool isq = col0 < 1024;
            if (isq && row0 >= SEQ) return;
            const int cc = isq ? col0 : col0 - 1024; const int h = cc >> 8, nb = cc & 255;
            const float lgf = -__expf(lrate[h]), lgb = -__expf(lrate[4 + h]);
            extern __shared__ __attribute__((aligned(16))) unsigned char smem_k[];
            bf16_t* kst = (bf16_t*)(smem_k + 98304 + (threadIdx.x >> 6) * 4608);
            const bool latT = row0 < SEQ;
            const int lr00 = row0 + fq * 4;
            const float pf0 = latT ? (float)(256 + lr00) : (float)(lr00 - SEQ);
            const float Cc = latT ? 8703.f : 255.f;
            const int a0 = lr00 & 127;
            const float ef0 = 0.0625f * __expf((float)(127 - a0) * lgf), eb0 = 0.0625f * __expf((float)a0 * lgb);
            const float efs = __expf(-lgf), ebs = __expf(lgb), efs16 = __expf(-16.f * lgf), ebs16 = __expf(16.f * lgb);
#pragma unroll
            for (int pr = 0; pr < 2; ++pr) {
                const int f = ((nb + pr * 32) >> 5) * 16 + fr;
                const float inv = exp2f(-(float)f * (13.287712379549449f / 127.f));
                float s1, c1, s16, c16, sC, cC, sm, cm;
                fast_sincos(inv, s1, c1); fast_sincos(16.f * inv, s16, c16); fast_sincos(Cc * inv, sC, cC); fast_sincos(pf0 * inv, sm, cm);
                float efm = ef0, ebm = eb0;
                uint2 kbp1[4], kbp2[4];
#pragma unroll
                for (int mt = 0; mt < 4; ++mt) { kbp1[mt] = make_uint2(0, 0); kbp2[mt] = kbp1[mt]; }
#pragma unroll
                for (int mt = 0; mt < 4; ++mt) {
                    float of1[4], of2[4], ob1[4], ob2[4];
                    float sf = sm, cf = cm, mf = efm, mb = ebm;
#pragma unroll
                    for (int j = 0; j < 4; ++j) {
                        const float x1 = acc[mt][2 * pr][j], x2 = acc[mt][2 * pr + 1][j];
                        const float cb = cC * cf + sC * sf, sb = sC * cf - cC * sf;
                        const float wf = isq ? 1.f : mf, wb = isq ? 1.f : mb;
                        of1[j] = (x1 * cf - x2 * sf) * wf; of2[j] = (x2 * cf + x1 * sf) * wf;
                        ob1[j] = (x1 * cb - x2 * sb) * wb; ob2[j] = (x2 * cb + x1 * sb) * wb;
                        const float cn = cf * c1 - sf * s1, sn = sf * c1 + cf * s1; cf = cn; sf = sn;
                        mf *= efs; mb *= ebs;
                    }
                    { const float cn = cm * c16 - sm * s16, sn = sm * c16 + cm * s16; cm = cn; sm = sn; efm *= efs16; ebm *= ebs16; }
                    const int lr0 = row0 + mt * 16 + fq * 4;
                    if (isq) {
#pragma unroll
                        for (int j = 0; j < 4; ++j) {
                            bf16_t* of = q1 + (size_t)(lr0 + j) * 1024 + h * 256 + f; bf16_t* ob = of + (size_t)SEQ * 1024;
                            of[0] = f2bf(of1[j]); of[128] = f2bf(of2[j]); ob[0] = f2bf(ob1[j]); ob[128] = f2bf(ob2[j]);
                        }
                    } else {
                        uint2 t;
                        t.x = pk2(of1[0], of1[1]); t.y = pk2(of1[2], of1[3]); *(uint2*)(kst + fr * 72 + mt * 16 + fq * 4) = t;
                        t.x = pk2(of2[0], of2[1]); t.y = pk2(of2[2], of2[3]); *(uint2*)(kst + (16 + fr) * 72 + mt * 16 + fq * 4) = t;
                        kbp1[mt].x = pk2(ob1[0], ob1[1]); kbp1[mt].y = pk2(ob1[2], ob1[3]); kbp2[mt].x = pk2(ob2[0], ob2[1]); kbp2[mt].y = pk2(ob2[2], ob2[3]);
                    }
                }
                if (!isq) {
                    const int f0 = ((nb + pr * 32) >> 5) * 16;
                    bf16_t* kdst = kz + (size_t)(h * 256 + f0) * RB + row0;
#pragma unroll
                    for (int i = 0; i < 4; ++i) { const int pc = lane + 64 * i; const int c = pc >> 3, ch = pc & 7;
                        *(uint4*)(kdst + (size_t)((c & 15) + (c >> 4) * 128) * RB + ch * 8) = *(const uint4*)(kst + c * 72 + ch * 8); }
#pragma unroll
                    for (int mt = 0; mt < 4; ++mt) { *(uint2*)(kst + fr * 72 + mt * 16 + fq * 4) = kbp1[mt]; *(uint2*)(kst + (16 + fr) * 72 + mt * 16 + fq * 4) = kbp2[mt]; }
                    kdst += (size_t)1024 * RB;
#pragma unroll
                    for (int i = 0; i < 4; ++i) { const int pc = lane + 64 * i; const int c = pc >> 3, ch = pc & 7;
                        *(uint4*)(kdst + (size_t)((c & 15) + (c >> 4) * 128) * RB + ch * 8) = *(const uint4*)(kst + c * 72 + ch * 8); }
                }
            }
        } else if (col0 < 4096) {
            const int vc = col0 - 2048;
            epi_store_cols_bf16(acc, v1 + (size_t)vc * RB + row0, (size_t)RB, lane);
        } else {
            if (row0 >= SEQ) return;
            const int dir = col0 >= 6144; const int gc = col0 - 4096 - dir * 2048;
            bf16_t* dst = sg + (size_t)dir * SEQ * 2048;
#pragma unroll
            for (int mt = 0; mt < 4; ++mt)
#pragma unroll
                for (int nt = 0; nt < 4; ++nt)
#pragma unroll
                    for (int j = 0; j < 4; ++j) dst[(size_t)(row0 + mt * 16 + fq * 4 + j) * 2048 + gc + nt * 16 + fr] = f2bf(siluf(acc[mt][nt][j]));
        }
    }
};

__device__ __forceinline__ void convert_w(const float* __restrict__ src, bf16_t* __restrict__ dst, int K, int N, int unit, bool perm, unsigned char* smem) {
    float* t = (float*)smem;
    const int tid = threadIdx.x; const int nkb = K / 64; const int kb = unit % nkb, nb = unit / nkb;
    __syncthreads();
#pragma unroll
    for (int i = 0; i < 2; ++i) {
        const int k = (tid >> 4) + 32 * i, n = (tid & 15) * 4;
        const float4 v = *(const float4*)(src + (size_t)(kb * 64 + k) * N + nb * 64 + n);
        t[k * 65 + n] = v.x; t[k * 65 + n + 1] = v.y; t[k * 65 + n + 2] = v.z; t[k * 65 + n + 3] = v.w;
    }
    __syncthreads();
    const int n = tid >> 3, k0 = (tid & 7) * 8;
    int no = nb * 64 + n;
    if (perm && no < 2048) { const int hb = no & ~255, d = no & 255; const int half = d >> 7, ip = d & 127; no = hb + (ip >> 4) * 32 + half * 16 + (ip & 15); }
    uint4 o;
    o.x = pk2(t[(k0 + 0) * 65 + n], t[(k0 + 1) * 65 + n]); o.y = pk2(t[(k0 + 2) * 65 + n], t[(k0 + 3) * 65 + n]);
    o.z = pk2(t[(k0 + 4) * 65 + n], t[(k0 + 5) * 65 + n]); o.w = pk2(t[(k0 + 6) * 65 + n], t[(k0 + 7) * 65 + n]);
    *(uint4*)(dst + (size_t)no * K + kb * 64 + k0) = o;
}

__device__ __forceinline__ void mod_unit(const Params& p, int unit, unsigned char* smem) {
    float* sc = (float*)smem;
    float* red = sc + 3072;
    const int tid = threadIdx.x, lane = tid & 63, w = tid >> 6;
    const int layer = unit / 96, n0 = (unit % 96) * 64;
    __syncthreads();
    for (int i = tid; i < 3072; i += NT) { const int v = i >> 10, k = i & 1023; const float cv = v < 2 ? p.c[v * 1024 + k] : p.c_ctx[k]; sc[i] = siluf(cv); }
    __syncthreads();
    const float* W = p.ada_w + (size_t)layer * 1024 * 6144 + n0 + lane;
    float a0 = 0.f, a1 = 0.f, a2 = 0.f;
#pragma unroll 8
    for (int k = w * 128; k < w * 128 + 128; ++k) { const float wv = W[(size_t)k * 6144]; a0 += sc[k] * wv; a1 += sc[1024 + k] * wv; a2 += sc[2048 + k] * wv; }
    red[(w * 3 + 0) * 64 + lane] = a0; red[(w * 3 + 1) * 64 + lane] = a1; red[(w * 3 + 2) * 64 + lane] = a2;
    __syncthreads();
    if (tid < 192) {
        const int v = tid >> 6; float s = 0.f;
        for (int ww = 0; ww < 8; ++ww) s += red[(ww * 3 + v) * 64 + lane];
        float* mod = (float*)(p.ws + OFF_MOD);
        mod[(layer * 3 + v) * 6144 + n0 + lane] = s + p.ada_b[layer * 6144 + n0 + lane];
    }
}

__device__ __forceinline__ void filter_unit(const Params& p, int L, int j0, float* hT, float* pn, unsigned char* smem) {
    float* zf = (float*)smem;
    float* h1 = zf + 32 * 36;
    float* h2 = h1 + 32 * 64;
    float* w1s = h2 + 32 * 64;
    float* w2s = w1s + 33 * 64;
    float* bfs = w2s + 64 * 64;
    const int tid = threadIdx.x;
    __syncthreads();
    for (int i = tid; i < 33 * 64; i += NT) w1s[i] = p.hy_w1[i];
    for (int i = tid; i < 64 * 64; i += NT) w2s[i] = p.hy_w2[i];
    if (tid < 64) { bfs[tid] = p.hy_b1[tid]; bfs[64 + tid] = p.hy_b2[tid]; bfs[128 + tid] = p.hy_freq[tid]; }
    for (int i = tid; i < 32 * 33; i += NT) {
        const int r = i / 33, f = i % 33; const float t = (float)(j0 + r) / (float)L; float v;
        if (f == 0) v = t;
        else { const int kb = (f - 1) & 15; const float band = 1e-4f + (float)kb * ((15.f - 1e-4f) / 15.f); const float ang = 6.283185307179586f * t * band; float s, c; fast_sincos(ang, s, c); v = (f <= 16) ? c : -s; }
        zf[r * 36 + f] = v;
    }
    __syncthreads();
    {
        const int r = tid >> 4, o0 = (tid & 15) * 4;
        float a0 = bfs[o0], a1 = bfs[o0 + 1], a2 = bfs[o0 + 2], a3 = bfs[o0 + 3];
#pragma unroll 11
        for (int f = 0; f < 33; ++f) { const float z = zf[r * 36 + f]; const float4 w = *(const float4*)(w1s + f * 64 + o0); a0 += z * w.x; a1 += z * w.y; a2 += z * w.z; a3 += z * w.w; }
        float s_, c_;
        fast_sincos(bfs[128 + o0] * a0, s_, c_); h1[r * 64 + o0] = s_; fast_sincos(bfs[128 + o0 + 1] * a1, s_, c_); h1[r * 64 + o0 + 1] = s_;
        fast_sincos(bfs[128 + o0 + 2] * a2, s_, c_); h1[r * 64 + o0 + 2] = s_; fast_sincos(bfs[128 + o0 + 3] * a3, s_, c_); h1[r * 64 + o0 + 3] = s_;
    }
    __syncthreads();
    {
        const int r = tid >> 4, o0 = (tid & 15) * 4;
        float a0 = bfs[64 + o0], a1 = bfs[64 + o0 + 1], a2 = bfs[64 + o0 + 2], a3 = bfs[64 + o0 + 3];
#pragma unroll 16
        for (int f = 0; f < 64; ++f) { const float z = h1[r * 64 + f]; const float4 w = *(const float4*)(w2s + f * 64 + o0); a0 += z * w.x; a1 += z * w.y; a2 += z * w.z; a3 += z * w.w; }
        float s_, c_;
        fast_sincos(bfs[128 + o0] * a0, s_, c_); h2[r * 64 + o0] = s_; fast_sincos(bfs[128 + o0 + 1] * a1, s_, c_); h2[r * 64 + o0 + 1] = s_;
        fast_sincos(bfs[128 + o0 + 2] * a2, s_, c_); h2[r * 64 + o0 + 2] = s_; fast_sincos(bfs[128 + o0 + 3] * a3, s_, c_); h2[r * 64 + o0 + 3] = s_;
    }
    __syncthreads();
    for (int cc = 0; cc < 2; ++cc) {
        const int col = tid + cc * 512;
        float wr[64];
#pragma unroll
        for (int k = 0; k < 64; ++k) wr[k] = p.hy_w3[k * 1024 + col];
        const float dec = fabsf(p.hy_decay[col]); float ss = 0.f;
        float* dst = hT + (size_t)col * L + j0;
#pragma unroll 1
        for (int rb = 0; rb < 32; rb += 4) {
            float a0 = 0.f, a1 = 0.f, a2 = 0.f, a3 = 0.f;
#pragma unroll
            for (int k4 = 0; k4 < 64; k4 += 4) {
                const float4 h0 = *(const float4*)(h2 + (rb + 0) * 64 + k4), h1v = *(const float4*)(h2 + (rb + 1) * 64 + k4), h2v = *(const float4*)(h2 + (rb + 2) * 64 + k4), h3v = *(const float4*)(h2 + (rb + 3) * 64 + k4);
                a0 += h0.x * wr[k4] + h0.y * wr[k4 + 1] + h0.z * wr[k4 + 2] + h0.w * wr[k4 + 3];
                a1 += h1v.x * wr[k4] + h1v.y * wr[k4 + 1] + h1v.z * wr[k4 + 2] + h1v.w * wr[k4 + 3];
                a2 += h2v.x * wr[k4] + h2v.y * wr[k4 + 1] + h2v.z * wr[k4 + 2] + h2v.w * wr[k4 + 3];
                a3 += h3v.x * wr[k4] + h3v.y * wr[k4 + 1] + h3v.z * wr[k4 + 2] + h3v.w * wr[k4 + 3];
            }
            const float invL = 1.f / (float)L;
            a0 *= __expf(-(float)(j0 + rb) * invL * dec); a1 *= __expf(-(float)(j0 + rb + 1) * invL * dec); a2 *= __expf(-(float)(j0 + rb + 2) * invL * dec); a3 *= __expf(-(float)(j0 + rb + 3) * invL * dec);
            if (!(cc == 1 && j0 + rb == 0)) ss += a0 * a0;
            ss += a1 * a1 + a2 * a2 + a3 * a3;
            *(float4*)(dst + rb) = make_float4(a0, a1, a2, a3);
        }
        pn[col] = ss;
    }
}

__device__ __forceinline__ void normmod_row(const float* __restrict__ src, const float* __restrict__ g, const float* __restrict__ sh, const float* __restrict__ sc, bf16_t* __restrict__ dst, int lane) {
    float4 v[4]; float ss = 0.f;
#pragma unroll
    for (int i = 0; i < 4; ++i) { v[i] = *(const float4*)(src + i * 256 + lane * 4); ss += v[i].x * v[i].x + v[i].y * v[i].y + v[i].z * v[i].z + v[i].w * v[i].w; }
#pragma unroll
    for (int o = 32; o >= 1; o >>= 1) ss += __shfl_xor(ss, o);
    const float rs = rsqrtf(ss * (1.f / 1024.f) + 1e-6f);
#pragma unroll
    for (int i = 0; i < 4; ++i) {
        const int c0 = i * 256 + lane * 4;
        const float4 gg = *(const float4*)(g + c0), s1 = *(const float4*)(sh + c0), s2 = *(const float4*)(sc + c0);
        uint2 o; o.x = pk2(v[i].x * rs * gg.x * (1.f + s2.x) + s1.x, v[i].y * rs * gg.y * (1.f + s2.y) + s1.y);
        o.y = pk2(v[i].z * rs * gg.z * (1.f + s2.z) + s1.z, v[i].w * rs * gg.w * (1.f + s2.w) + s1.w);
        *(uint2*)(dst + c0) = o;
    }
}

struct RowMap {
    const float* lat; const float* ctx; int mode; int b;
    __device__ __forceinline__ const float* src(int r, int& vidx) const {
        if (mode == 2) { vidx = r / SEQ; return lat + (size_t)r * D; }
        const int bb = mode == 0 ? r / RB : b; const int i = mode == 0 ? r % RB : r;
        if (i < SEQ) { vidx = bb; return lat + (size_t)(bb * SEQ + i) * D; }
        vidx = 2; return ctx + (size_t)(bb * CTXL + i - SEQ) * D;
    }
};
__device__ __forceinline__ void normmod_phase(int M, const RowMap& rm, const float* __restrict__ g, const float* __restrict__ modl, int sh_off, int sc_off, bf16_t* __restrict__ dst, int gw, int nw, int lane) {
    const int per = (M + nw - 1) / nw; const int r0 = gw * per; const int r1 = (r0 + per < M) ? r0 + per : M;
    if (r0 >= r1) return;
    int curv = -1; float4 ca[4], cb[4];
    int vidx; const float* s = rm.src(r0, vidx);
    float4 v[4];
#pragma unroll
    for (int i = 0; i < 4; ++i) v[i] = *(const float4*)(s + i * 256 + lane * 4);
#pragma unroll 1
    for (int r = r0; r < r1; ++r) {
        float4 nv[4]; int nvidx = vidx;
        { const int rn = (r + 1 < r1) ? r + 1 : r; const float* ns = rm.src(rn, nvidx);
#pragma unroll
            for (int i = 0; i < 4; ++i) nv[i] = *(const float4*)(ns + i * 256 + lane * 4); }
        if (vidx != curv) {
            curv = vidx; const float* mv = modl + vidx * 6144;
#pragma unroll
            for (int i = 0; i < 4; ++i) { const int c0 = i * 256 + lane * 4; const float4 gg = *(const float4*)(g + c0), s1 = *(const float4*)(mv + sh_off + c0), s2 = *(const float4*)(mv + sc_off + c0);
                ca[i] = make_float4(gg.x * (1.f + s2.x), gg.y * (1.f + s2.y), gg.z * (1.f + s2.z), gg.w * (1.f + s2.w)); cb[i] = s1; }
        }
        float ss = 0.f;
#pragma unroll
        for (int i = 0; i < 4; ++i) ss += v[i].x * v[i].x + v[i].y * v[i].y + v[i].z * v[i].z + v[i].w * v[i].w;
#pragma unroll
        for (int o = 32; o >= 1; o >>= 1) ss += __shfl_xor(ss, o);
        const float rs = rsqrtf(ss * (1.f / 1024.f) + 1e-6f);
        bf16_t* d = dst + (size_t)r * D;
#pragma unroll
        for (int i = 0; i < 4; ++i) {
            uint2 o; o.x = pk2(v[i].x * rs * ca[i].x + cb[i].x, v[i].y * rs * ca[i].y + cb[i].y); o.y = pk2(v[i].z * rs * ca[i].z + cb[i].z, v[i].w * rs * ca[i].w + cb[i].w);
            *(uint2*)(d + i * 256 + lane * 4) = o;
        }
#pragma unroll
        for (int i = 0; i < 4; ++i) v[i] = nv[i];
        vidx = nvidx;
    }
}

__device__ __forceinline__ void fft_fwd(float2* X, const float2* __restrict__ tw, int tid) {
    for (int h = 8192; h >= 2; h >>= 2) {
        const int q = h >> 1, tsh = 8192 / h; const int lq = 31 - __clz(q);
        for (int g = tid; g < 4096; g += NT) {
            const int blk = g >> lq, off = g & (q - 1); const int base = blk * 2 * h + off;
            const float2 a = X[base], b = X[base + q], c = X[base + 2 * q], d = X[base + 3 * q];
            const float2 w1 = tw[off * tsh], w2 = tw[off * tsh * 2];
            const float2 a1 = cadd(a, c), c1 = cmul(csub(a, c), w1);
            const float2 b1 = cadd(b, d); const float2 t = csub(b, d); const float2 d1 = cmul(make_float2(t.y, -t.x), w1);
            X[base] = cadd(a1, b1); X[base + q] = cmul(csub(a1, b1), w2); X[base + 2 * q] = cadd(c1, d1); X[base + 3 * q] = cmul(csub(c1, d1), w2);
        }
        __syncthreads();
    }
}
__device__ __forceinline__ void fft_inv(float2* X, const float2* __restrict__ tw, int tid) {
    for (int h = 2; h <= 8192; h <<= 2) {
        const int q = h >> 1, tsh = 8192 / h; const int lq = 31 - __clz(q);
        for (int g = tid; g < 4096; g += NT) {
            const int blk = g >> lq, off = g & (q - 1); const int base = blk * 2 * h + off;
            const float2 a = X[base], b = X[base + q], c = X[base + 2 * q], d = X[base + 3 * q];
            float2 w1 = tw[off * tsh], w2 = tw[off * tsh * 2]; w1.y = -w1.y; w2.y = -w2.y;
            const float2 bb = cmul(b, w2), dd = cmul(d, w2);
            const float2 a1 = cadd(a, bb), b1 = csub(a, bb), c1 = cadd(c, dd), d1 = csub(c, dd);
            const float2 cc = cmul(c1, w1); const float2 t = cmul(d1, w1); const float2 d2 = make_float2(-t.y, t.x);
            X[base] = cadd(a1, cc); X[base + 2 * q] = csub(a1, cc); X[base + q] = cadd(b1, d2); X[base + 3 * q] = csub(b1, d2);
        }
        __syncthreads();
    }
}

__device__ __forceinline__ void attn_unit(const Params& p, int b, int kh, int half, int qrow0  , int nloc  , unsigned char* smem) {
    const bf16_t* qr = (const bf16_t*)(p.ws + OFF_QR); const bf16_t* kr = (const bf16_t*)(p.ws + OFF_KR); const bf16_t* vT = (const bf16_t*)(p.ws + OFF_VT);
    bf16_t* ao = (bf16_t*)(p.ws + OFF_AO);
    bf16_t* Ks = (bf16_t*)smem;
    bf16_t* Vs = Ks + 64 * 72;
    int tid = threadIdx.x; asm volatile("" : "+v"(tid));
    const int lane = tid & 63, w = tid >> 6, fr = lane & 15, fq = lane >> 4;
    const int g = half * 2 + (w >> 2), qq = w & 3, h = kh * 4 + g;
    const int myq0 = qrow0 + qq * 32;
    bf16x8 qf[2][2];
#pragma unroll
    for (int qt = 0; qt < 2; ++qt)
#pragma unroll
        for (int ks = 0; ks < 2; ++ks) qf[qt][ks] = *(const bf16x8*)(qr + (size_t)(myq0 + qt * 16 + fr) * 512 + h * 64 + ks * 32 + fq * 8);
    f32x4 o[2][4];
#pragma unroll
    for (int i = 0; i < 2; ++i)
#pragma unroll
        for (int j = 0; j < 4; ++j) o[i][j] = (f32x4){0.f, 0.f, 0.f, 0.f};
    const float sink = p.attn_sink[h];
    float m[2], l[2];
#pragma unroll
    for (int qt = 0; qt < 2; ++qt) { m[qt] = sink; l[qt] = 1.f; }
    int loc0 = 0, nlt = 0;
    if (nloc >= 0) { int lo = (nloc - 1) * 128; if (lo < 0) lo = 0; int hi = (nloc + 2) * 128; if (hi > SEQ) hi = SEQ; loc0 = lo; nlt = (hi - lo) / 64; }
    const int ntile = nlt + 4;
    const int sr_ = tid >> 3, sch_ = (tid & 7) * 8;
    uint4 kpre, vpre;
    { const int krow00 = nlt > 0 ? b * RB + loc0 : b * RB + SEQ;
      kpre = *(const uint4*)(kr + (size_t)(krow00 + sr_) * 128 + kh * 64 + sch_); vpre = *(const uint4*)(vT + (size_t)(kh * 64 + sr_) * MROWS + krow00 + sch_); }
#pragma unroll 2
    for (int t = 0; t < ntile; ++t) {
        const bool isloc = t < nlt;
        const int kpos0 = isloc ? loc0 + t * 64 : 0;
        __syncthreads();
        *(uint4*)(Ks + sr_ * 72 + sch_) = kpre; *(uint4*)(Vs + sr_ * 72 + sch_) = vpre;
        if (t + 1 < ntile) { const int t1 = t + 1; const int krow1 = t1 < nlt ? b * RB + loc0 + t1 * 64 : b * RB + SEQ + (t1 - nlt) * 64;
            kpre = *(const uint4*)(kr + (size_t)(krow1 + sr_) * 128 + kh * 64 + sch_); vpre = *(const uint4*)(vT + (size_t)(kh * 64 + sr_) * MROWS + krow1 + sch_); }
        __syncthreads();
        f32x4 st[4][2];
#pragma unroll
        for (int i = 0; i < 4; ++i)
#pragma unroll
            for (int j = 0; j < 2; ++j) st[i][j] = (f32x4){0.f, 0.f, 0.f, 0.f};
#pragma unroll
        for (int ks = 0; ks < 2; ++ks) {
#pragma unroll
            for (int kt = 0; kt < 4; ++kt) {
                const bf16x8 kf = *(const bf16x8*)(Ks + (kt * 16 + fr) * 72 + ks * 32 + fq * 8);
#pragma unroll
                for (int qt = 0; qt < 2; ++qt) st[kt][qt] = mfma16(kf, qf[qt][ks], st[kt][qt]);
            }
        }
        if (isloc) {
            const int qpb = nloc * 128 + qq * 32 + fr;
#pragma unroll
            for (int kt = 0; kt < 4; ++kt)
#pragma unroll
                for (int qt = 0; qt < 2; ++qt)
#pragma unroll
                    for (int j = 0; j < 4; ++j) { const int dlt = (qpb + qt * 16) - (kpos0 + kt * 16 + fq * 4 + j); if (dlt > 128 || dlt < -128) st[kt][qt][j] = -1e30f; }
        }
#pragma unroll
        for (int qt = 0; qt < 2; ++qt) {
            float mx = -3e38f;
#pragma unroll
            for (int kt = 0; kt < 4; ++kt)
#pragma unroll
                for (int j = 0; j < 4; ++j) mx = fmaxf(mx, st[kt][qt][j]);
            mx = fmaxf(mx, __shfl_xor(mx, 16)); mx = fmaxf(mx, __shfl_xor(mx, 32));
            const float mn = fmaxf(m[qt], mx); const float alpha = __expf(m[qt] - mn); m[qt] = mn;
            float sum = 0.f;
#pragma unroll
            for (int kt = 0; kt < 4; ++kt)
#pragma unroll
                for (int j = 0; j < 4; ++j) { const float sv = st[kt][qt][j]; const float pv = sv < -1e29f ? 0.f : __expf(sv - mn); st[kt][qt][j] = pv; sum += pv; }
            sum += __shfl_xor(sum, 16); sum += __shfl_xor(sum, 32);
            l[qt] = l[qt] * alpha + sum;
#pragma unroll
            for (int j = 0; j < 4; ++j) { const float al = __shfl(alpha, fq * 4 + j);
#pragma unroll
                for (int dt = 0; dt < 4; ++dt) o[qt][dt][j] *= al; }
        }
#pragma unroll
        for (int ks = 0; ks < 2; ++ks) {
            bf16x8 pf[2];
#pragma unroll
            for (int qt = 0; qt < 2; ++qt) {
                uint4 u4; u4.x = pk2(st[2 * ks][qt][0], st[2 * ks][qt][1]); u4.y = pk2(st[2 * ks][qt][2], st[2 * ks][qt][3]);
                u4.z = pk2(st[2 * ks + 1][qt][0], st[2 * ks + 1][qt][1]); u4.w = pk2(st[2 * ks + 1][qt][2], st[2 * ks + 1][qt][3]);
                pf[qt] = __builtin_bit_cast(bf16x8, u4);
            }
#pragma unroll
            for (int dt = 0; dt < 4; ++dt) {
                const uint2 lo = *(const uint2*)(Vs + (dt * 16 + fr) * 72 + ks * 32 + fq * 4);
                const uint2 hi = *(const uint2*)(Vs + (dt * 16 + fr) * 72 + ks * 32 + 16 + fq * 4);
                const bf16x8 vf = __builtin_bit_cast(bf16x8, make_uint4(lo.x, lo.y, hi.x, hi.y));
#pragma unroll
                for (int qt = 0; qt < 2; ++qt) o[qt][dt] = mfma16(pf[qt], vf, o[qt][dt]);
            }
        }
    }
#pragma unroll
    for (int qt = 0; qt < 2; ++qt) {
        const float il = 1.f / l[qt];
#pragma unroll
        for (int j = 0; j < 4; ++j) {
            const float s = __shfl(il, fq * 4 + j);
            bf16_t* dst = ao + (size_t)(myq0 + qt * 16 + fq * 4 + j) * 1024 + 512 + h * 64 + fr;
#pragma unroll
            for (int dt = 0; dt < 4; ++dt) dst[dt * 16] = f2bf(o[qt][dt][j] * s);
        }
    }
}


#define XB_TMO      128
#define XB_XCNT(j)  (256  + 64 * (j))
#define XB_XSUB(j)  (1280 + 64 * (j))
#define XB_XGEN(j)  (2304 + 64 * (j))
#define XB_TOP      3328
#define XB_TOPGEN   3392
#define XCD_BAR_WORDS 3456
#define XB_SPIN_CAP (1u << 20)
#define LAS __attribute__((address_space(3)))
__device__ __forceinline__ unsigned xb_ld(unsigned* p)              { return __hip_atomic_load(p, __ATOMIC_RELAXED, __HIP_MEMORY_SCOPE_AGENT); }
__device__ __forceinline__ unsigned xb_add(unsigned* p, unsigned v) { return __hip_atomic_fetch_add(p, v, __ATOMIC_RELAXED, __HIP_MEMORY_SCOPE_AGENT); }
__device__ __forceinline__ unsigned xb_xcc_id() { return (unsigned)__builtin_amdgcn_s_getreg((3 << 11) | 20) & 0xFu; }
#define XB_SPIN(cond, bar) do { unsigned _sp = 0; while (cond) { __builtin_amdgcn_s_sleep(1); \
    if ((++_sp & 255u) == 0u) { if (xb_ld(&(bar)[XB_TMO])) break; if (_sp > XB_SPIN_CAP) { atomicAdd(&(bar)[XB_TMO], 1u); break; } } } } while (0)
struct XcdBarrier { unsigned* bar; unsigned x; volatile LAS unsigned* st; };
__device__ __forceinline__ XcdBarrier xcd_barrier_post(unsigned* bar, volatile LAS unsigned* st) {
    XcdBarrier b; b.bar = bar; b.x = xb_xcc_id(); b.st = st;
    if (threadIdx.x == 0) (void)xb_add(&bar[XB_XCNT(b.x)], 1u);
    return b;
}
__device__ __forceinline__ void xcd_barrier_complete(unsigned* bar, unsigned x, unsigned& nloc, unsigned& nx) {
    const unsigned G = gridDim.x * gridDim.y * gridDim.z;
    unsigned sum, cnt, mine, sp = 0u;
    for (;;) {
        sum = 0u; cnt = 0u; mine = 0u;
#pragma unroll
        for (unsigned j = 0; j < 16; ++j) { const unsigned c = xb_ld(&bar[XB_XCNT(j)]); sum += c; cnt += (c > 0u) ? 1u : 0u; mine = (j == x) ? c : mine; }
        if (sum == G) break;
        __builtin_amdgcn_s_sleep(1);
        if ((++sp & 255u) == 0u) { if (xb_ld(&bar[XB_TMO])) break; if (sp > XB_SPIN_CAP) { atomicAdd(&bar[XB_TMO], 1u); break; } }
    }
    nloc = mine > 0u ? mine : 1u; nx = cnt > 0u ? cnt : 1u;
}
__device__ __forceinline__ void xcd_barrier(const XcdBarrier& b) {
    asm volatile("s_waitcnt vmcnt(0)" ::: "memory");
    __syncthreads();
    if (threadIdx.x == 0) {
        unsigned* bar = b.bar;
        __builtin_amdgcn_s_waitcnt(0);
        unsigned nloc = b.st[0], nx = b.st[1];
        if (nloc == 0u) { xcd_barrier_complete(bar, b.x, nloc, nx); b.st[0] = nloc; b.st[1] = nx; }
        const unsigned old = xb_add(&bar[XB_XSUB(b.x)], 1u);
        const unsigned gen = old / nloc;
        if (old + 1u == (gen + 1u) * nloc) {
            __builtin_amdgcn_fence(__ATOMIC_RELEASE, "agent");
            asm volatile("s_waitcnt vmcnt(0)" ::: "memory");
            const unsigned og = xb_add(&bar[XB_TOP], 1u);
            const unsigned tg = og / nx;
            if (og + 1u == (tg + 1u) * nx) xb_add(&bar[XB_TOPGEN], 1u);
            else XB_SPIN(xb_ld(&bar[XB_TOPGEN]) == tg, bar);
            __builtin_amdgcn_fence(__ATOMIC_ACQUIRE, "agent");
            xb_add(&bar[XB_XGEN(b.x)], 1u);
            asm volatile("s_waitcnt vmcnt(0)" ::: "memory");
        } else {
            XB_SPIN(xb_ld(&bar[XB_XGEN(b.x)]) == gen, bar);
            __builtin_amdgcn_fence(__ATOMIC_ACQUIRE, "agent");
            asm volatile("s_waitcnt vmcnt(0)" ::: "memory");
        }
    }
    __syncthreads();
}

__global__ void __launch_bounds__(NT) fwd_megakernel(Params p) {
    extern __shared__ __attribute__((aligned(16))) unsigned char smem[];
    cg::grid_group grid = cg::this_grid();
    __shared__ uint4 xb_words;
    if (threadIdx.x == 0) xb_words = make_uint4(0u, 0u, 0u, 0u);
    __syncthreads();
    const XcdBarrier xb = xcd_barrier_post((unsigned*)(p.ws + OFF_BAR), (volatile LAS unsigned*)&xb_words);
    const int tid = threadIdx.x, lane = tid & 63, wv = tid >> 6;
    const int nb = gridDim.x, bid = blockIdx.x;
    unsigned char* ws = p.ws;
    float* mod = (float*)(ws + OFF_MOD);
    float2* tw = (float2*)(ws + OFF_TW);
    float* xc = (float*)(ws + OFF_XC);
    bf16_t* Wt = (bf16_t*)(ws + OFF_WT);
    bf16_t* hA = (bf16_t*)(ws + OFF_HA);
    float* hT = (float*)(ws + OFF_HT); float* hTc = (float*)(ws + OFF_HTC); float* pn = (float*)(ws + OFF_PN);
    float2* Hf = (float2*)(ws + OFF_HF);
    bf16_t* ubuf = (bf16_t*)(ws + OFF_U);
    bf16_t* gT = (bf16_t*)(ws + OFF_GT); bf16_t* ao = (bf16_t*)(ws + OFF_AO); bf16_t* hid = (bf16_t*)(ws + OFF_HID);
    float* zT = (float*)((unsigned char*)p.out + DO_ZT); bf16_t* x0T = (bf16_t*)((unsigned char*)p.out + DO_X0T);

    {
        int tid = threadIdx.x; asm volatile("" : "+v"(tid)); const int lane = tid & 63, wv = tid >> 6; (void)lane; (void)wv;
        const int nW = 576 + 256 + 1024 + 1024;
        const int nU = nW + 192 + 16 + 256 + 8;
        for (int u = bid; u < nU; u += nb) {
            if (u < 576) convert_w(p.ev_w_in, Wt + W0_IN, 1024, 2304, u, false, smem);
            else if (u < 832) convert_w(p.ev_w_out, Wt + W0_OUT, 1024, 1024, u - 576, false, smem);
            else if (u < 1856) convert_w(p.mlp_w1, Wt + W0_1, 1024, 4096, u - 832, false, smem);
            else if (u < 2880) convert_w(p.mlp_w2, Wt + W0_2, 4096, 1024, u - 1856, false, smem);
            else if (u < nW + 192) mod_unit(p, u - nW, smem);
            else if (u < nW + 208) { const int k = (u - nW - 192) * 512 + tid; float s, c; sincospif((float)k / 8192.f, &s, &c); tw[k] = make_float2(c, -s); }
            else if (u < nW + 208 + 256) { const int fu = u - nW - 208; filter_unit(p, 8192, fu * 32, hT, pn + fu * 1024, smem); }
            else { const int fu = u - nW - 208 - 256; filter_unit(p, 256, fu * 32, hTc, pn + (256 + fu) * 1024, smem); }
        }
    }
    grid.sync();
    {
        int tid = threadIdx.x; asm volatile("" : "+v"(tid)); const int lane = tid & 63, wv = tid >> 6; (void)lane; (void)wv;
        const int nNorm = 0;
        { RowMap rm{p.x, p.ctx, 0, 0}; normmod_phase(MROWS, rm, p.norm_mix_g, mod, 0, 1024, hA, bid * 8 + wv, nb * 8, lane); }
        for (int u = bid; u < 256; u += nb) {
            {
                int tid = threadIdx.x; asm volatile("" : "+v"(tid)); const int lane = tid & 63, wv = tid >> 6;
                const int cA = u, cB = u + 256; float2* X = (float2*)smem; float* red = (float*)(smem + 131072);
                __syncthreads();
                float pa = 0.f, pb = 0.f;
                if (tid < 256) { pa = pn[tid * 1024 + cA] + pn[tid * 1024 + 512 + cA]; pb = pn[tid * 1024 + cB] + pn[tid * 1024 + 512 + cB]; }
#pragma unroll
                for (int o = 32; o >= 1; o >>= 1) { pa += __shfl_xor(pa, o); pb += __shfl_xor(pb, o); }
                if (lane == 0) { red[wv] = pa; red[8 + wv] = pb; }
                __syncthreads();
                float ta = 0.f, tb = 0.f; for (int i = 0; i < 8; ++i) { ta += red[i]; tb += red[8 + i]; }
                const float sa = 1.f / (sqrtf(ta) * 16384.f), sb = 1.f / (sqrtf(tb) * 16384.f);
                const float* a0 = hT + (size_t)cA * 8192; const float* a1 = hT + (size_t)(512 + cA) * 8192;
                const float* b0 = hT + (size_t)cB * 8192; const float* b1 = hT + (size_t)(512 + cB) * 8192;
#pragma unroll 1
                for (int m0 = tid; m0 < 8192; m0 += NT * 8) {
                    float pa_[8], pb_[8], na_[8], nb_[8];
#pragma unroll
                    for (int k = 0; k < 8; ++k) { const int m = m0 + k * NT; pa_[k] = a0[m]; pb_[k] = b0[m]; na_[k] = a1[m]; nb_[k] = b1[m]; }
#pragma unroll
                    for (int k = 0; k < 8; ++k) { const int m = m0 + k * NT; X[m] = make_float2(pa_[k] * sa, pb_[k] * sb); if (m > 0) X[16384 - m] = make_float2(na_[k] * sa, nb_[k] * sb); }
                }
                if (tid == 0) X[8192] = make_float2(0.f, 0.f);
                __syncthreads();
                fft_fwd(X, tw, tid);
                float2* dA = Hf + (size_t)cA * 16384; float2* dB = Hf + (size_t)cB * 16384;
                for (int mI = tid; mI < 16384; mI += NT) {
                    const int k = (int)(__brev((unsigned)mI) >> 18); const int m2 = (int)(__brev((unsigned)((16384 - k) & 16383)) >> 18);
                    const float2 x1 = X[mI], x2 = X[m2];
                    dA[mI] = make_float2(0.5f * (x1.x + x2.x), 0.5f * (x1.y - x2.y));
                    dB[mI] = make_float2(0.5f * (x1.y + x2.y), -0.5f * (x1.x - x2.x));
                }
            }
        }
    }
    xcd_barrier(xb);
    { EpiWin e{ubuf, (bf16_t*)(ws + OFF_QR), (bf16_t*)(ws + OFF_KR), (bf16_t*)(ws + OFF_VT)}; gemm_phase(hA, D, Wt + W0_IN, 1024, MROWS, 2304, 1024, e, smem); }
    xcd_barrier(xb);
    {
        int tid = threadIdx.x; asm volatile("" : "+v"(tid)); const int lane = tid & 63, wv = tid >> 6; (void)lane; (void)wv;
        float* zs = (float*)smem; float* xs = zs + 512 * 33;
        for (int u = bid; u < MROWS / 32; u += nb) {
            const int r0 = u * 32; const int i0 = r0 % RB; const int segEnd = (i0 < SEQ) ? SEQ : RB; const int segBeg = (i0 < SEQ) ? 0 : SEQ;
            const int c = tid;
            float w[3][3], bb[3];
#pragma unroll
            for (int gI = 0; gI < 3; ++gI) { bb[gI] = p.hy_conv_b[gI * 512 + c];
#pragma unroll
                for (int k = 0; k < 3; ++k) w[gI][k] = p.hy_conv_w[k * 1536 + gI * 512 + c]; }
            float prev[3], cur[3], nxt[3];
#pragma unroll
            for (int gI = 0; gI < 3; ++gI) { prev[gI] = (i0 > segBeg) ? bf2f(ubuf[(size_t)(r0 - 1) * 1536 + gI * 512 + c]) : 0.f; cur[gI] = bf2f(ubuf[(size_t)r0 * 1536 + gI * 512 + c]); }
            __syncthreads();
#pragma unroll 1
            for (int tb = 0; tb < 32; tb += 8) {
                bf16_t nx[8][3];
                const int lastr = segEnd - 1 - i0 + r0;
#pragma unroll
                for (int k = 0; k < 8; ++k) { int rr = r0 + tb + k + 1; rr = rr > lastr ? lastr : rr;
#pragma unroll
                    for (int gI = 0; gI < 3; ++gI) nx[k][gI] = ubuf[(size_t)rr * 1536 + gI * 512 + c]; }
#pragma unroll
                for (int k = 0; k < 8; ++k) {
                    const int t = tb + k; const bool hasn = (i0 + t + 1) < segEnd;
                    float cv[3];
#pragma unroll
                    for (int gI = 0; gI < 3; ++gI) { nxt[gI] = hasn ? bf2f(nx[k][gI]) : 0.f; cv[gI] = prev[gI] * w[gI][0] + cur[gI] * w[gI][1] + nxt[gI] * w[gI][2] + bb[gI]; prev[gI] = cur[gI]; cur[gI] = nxt[gI]; }
                    zs[c * 33 + t] = cv[2] * cv[1]; xs[c * 33 + t] = cv[0];
                }
            }
            __syncthreads();
            for (int i = tid; i < 512 * 8; i += NT) {
                const int cc = i >> 3, t4 = (i & 7) * 4;
                *(float4*)(zT + (size_t)cc * MROWS + r0 + t4) = make_float4(zs[cc * 33 + t4], zs[cc * 33 + t4 + 1], zs[cc * 33 + t4 + 2], zs[cc * 33 + t4 + 3]);
                uint2 o; o.x = pk2(xs[cc * 33 + t4], xs[cc * 33 + t4 + 1]); o.y = pk2(xs[cc * 33 + t4 + 2], xs[cc * 33 + t4 + 3]);
                *(uint2*)(x0T + (size_t)cc * MROWS + r0 + t4) = o;
            }
        }
    }
    xcd_barrier(xb);
    {
        int tid = threadIdx.x; asm volatile("" : "+v"(tid)); const int lane = tid & 63, wv = tid >> 6; (void)lane; (void)wv;
        for (int u = bid; u < 512 + 512 + 16 + 512; u += nb) {
            if (u < 512) {
                int tid = threadIdx.x; asm volatile("" : "+v"(tid));
                const int c = u; float2* X = (float2*)smem;
                const float* z0 = zT + (size_t)c * MROWS; const float* z1 = z0 + RB;
                __syncthreads();
#pragma unroll 1
                for (int m0 = tid; m0 < 8192; m0 += NT * 8) {
                    float ra[8], rb[8];
#pragma unroll
                    for (int k = 0; k < 8; ++k) { ra[k] = z0[m0 + k * NT]; rb[k] = z1[m0 + k * NT]; }
#pragma unroll
                    for (int k = 0; k < 8; ++k) { X[m0 + k * NT] = make_float2(ra[k], rb[k]); X[8192 + m0 + k * NT] = make_float2(0.f, 0.f); }
                }
                __syncthreads();
                fft_fwd(X, tw, tid);
                const float2* hf = Hf + (size_t)c * 16384;
#pragma unroll 1
                for (int m0 = tid; m0 < 16384; m0 += NT * 8) {
                    float2 hv[8];
#pragma unroll
                    for (int k = 0; k < 8; ++k) hv[k] = hf[m0 + k * NT];
#pragma unroll
                    for (int k = 0; k < 8; ++k) X[m0 + k * NT] = cmul(X[m0 + k * NT], hv[k]);
                }
                __syncthreads();
                fft_inv(X, tw, tid);
                const float bias = p.hy_bias[c];
                const bf16_t* xa = x0T + (size_t)c * MROWS; bf16_t* g0 = gT + (size_t)c * MROWS;
#pragma unroll 1
                for (int t0 = tid; t0 < 8192; t0 += NT * 4) {
                    bf16_t xa0[4], xa1[4]; float za[4], zb[4];
#pragma unroll
                    for (int k = 0; k < 4; ++k) { const int t = t0 + k * NT; xa0[k] = xa[t]; xa1[k] = xa[RB + t]; za[k] = z0[t]; zb[k] = z1[t]; }
#pragma unroll
                    for (int k = 0; k < 4; ++k) { const int t = t0 + k * NT; const float2 y = X[t];
                        g0[t] = f2bf(bf2f(xa0[k]) * (y.x + za[k] * bias)); g0[RB + t] = f2bf(bf2f(xa1[k]) * (y.y + zb[k] * bias)); }
                }
            } else if (u < 1024) {
                const int uu = u - 512; const int half = uu & 1, kh = (uu >> 1) & 1, n = (uu >> 2) & 63, b = uu >> 8;
                attn_unit(p, b, kh, half, b * RB + n * 128, n, smem);
            } else if (u < 1040) {
                const int uu = u - 1024; const int half = uu & 1, kh = (uu >> 1) & 1, qb = (uu >> 2) & 1, b = uu >> 3;
                attn_unit(p, b, kh, half, b * RB + SEQ + qb * 128, -1, smem);
            } else {
                int tid = threadIdx.x; asm volatile("" : "+v"(tid)); const int lane = tid & 63, wv = tid >> 6;
                const int c = u - 1040; float* hs = (float*)smem; float* zs = hs + 512; float* red = zs + 512;
                __syncthreads();
                float v = 0.f;
                { const int lag = tid - 255; if (tid < 511) v = lag >= 0 ? hTc[(size_t)c * 256 + lag] : hTc[(size_t)(512 + c) * 256 - lag]; }
                hs[tid] = v; float ss = v * v;
                { const int b = tid >> 8, s = tid & 255; zs[tid] = zT[(size_t)c * MROWS + b * RB + SEQ + s]; }
#pragma unroll
                for (int o = 32; o >= 1; o >>= 1) ss += __shfl_xor(ss, o);
                if (lane == 0) red[wv] = ss;
                __syncthreads();
                float tot = 0.f; for (int i = 0; i < 8; ++i) tot += red[i];
                const float inv = 1.f / sqrtf(tot);
                const int b = tid >> 8, t = tid & 255; float a = 0.f;
                for (int s = 0; s < 256; ++s) a += hs[t - s + 255] * zs[b * 256 + s];
                const size_t idx = (size_t)c * MROWS + b * RB + SEQ + t;
                gT[idx] = f2bf(bf2f(x0T[idx]) * (a * inv + zs[tid] * p.hy_bias[c]));
            }
        }
    }
    xcd_barrier(xb);
    {
        int tid = threadIdx.x; asm volatile("" : "+v"(tid)); const int lane = tid & 63, wv = tid >> 6; (void)lane; (void)wv;
        bf16_t* ts = (bf16_t*)smem;
        for (int u = bid; u < 8 * (MROWS / 64); u += nb) {
            const int cb = u & 7, rb = u >> 3;
            __syncthreads();
            { const int c = tid >> 3, r8 = (tid & 7) * 8; const uint4 v = *(const uint4*)(gT + (size_t)(cb * 64 + c) * MROWS + rb * 64 + r8);
#pragma unroll
              for (int i = 0; i < 8; ++i) ts[c * 66 + r8 + i] = u4e(v, i); }
            __syncthreads();
            { const int r = tid >> 3, c8 = (tid & 7) * 8; uint4 o;
              o.x = (unsigned)ts[(c8 + 0) * 66 + r] | ((unsigned)ts[(c8 + 1) * 66 + r] << 16); o.y = (unsigned)ts[(c8 + 2) * 66 + r] | ((unsigned)ts[(c8 + 3) * 66 + r] << 16);
              o.z = (unsigned)ts[(c8 + 4) * 66 + r] | ((unsigned)ts[(c8 + 5) * 66 + r] << 16); o.w = (unsigned)ts[(c8 + 6) * 66 + r] | ((unsigned)ts[(c8 + 7) * 66 + r] << 16);
              *(uint4*)(ao + (size_t)(rb * 64 + r) * 1024 + cb * 64 + c8) = o; }
        }
    }
    xcd_barrier(xb);
    { EpiRes0 e{p.x, p.ctx, p.out, xc, mod, 2048}; gemm_phase(ao, 1024, Wt + W0_OUT, 1024, MROWS, 1024, 1024, e, smem); }
    xcd_barrier(xb);
    {
        int tid = threadIdx.x; asm volatile("" : "+v"(tid)); const int lane = tid & 63, wv = tid >> 6; (void)lane; (void)wv;
    { RowMap rm{p.out, xc, 0, 0}; normmod_phase(MROWS, rm, p.norm_mlp_g, mod, 3072, 4096, hA, bid * 8 + wv, nb * 8, lane); }
    }
    xcd_barrier(xb);
    { EpiRelu2 e{hid, 4096}; gemm_phase(hA, D, Wt + W0_1, 1024, MROWS, 4096, 1024, e, smem); }
    xcd_barrier(xb);
    { EpiRes0 e{p.out, xc, p.out, xc, mod, 5120}; gemm_phase<true>(hid, 4096, Wt + W0_2, 4096, MROWS, 1024, 4096, e, smem); }
    xcd_barrier(xb);
    const float* mod1 = mod + 3 * 6144;
    for (int u = bid; u < 2048 + 512 + 1024 + 1024; u += nb) {
        if (u < 2048) convert_w(p.od_w_in, Wt + W1_IN, 1024, 8192, u, true, smem);
        else if (u < 2560) convert_w(p.od_w_out, Wt + W1_OUT, 2048, 1024, u - 2048, false, smem);
        else if (u < 3584) convert_w(p.mlp_w1 + (size_t)1024 * 4096, Wt + W1_1, 1024, 4096, u - 2560, false, smem);
        else convert_w(p.mlp_w2 + (size_t)4096 * 1024, Wt + W1_2, 4096, 1024, u - 3584, false, smem);
    }
    bf16_t* q1 = (bf16_t*)(ws + OFF_Q1); bf16_t* kz = (bf16_t*)(ws + OFF_KZ); bf16_t* v1 = (bf16_t*)(ws + OFF_V1);
    bf16_t* inn = (bf16_t*)(ws + OFF_IN); bf16_t* sg = (bf16_t*)(ws + OFF_SG); float* ps = (float*)(ws + OFF_PS);
#pragma unroll 1
    for (int b = 0; b < 2; ++b) {
        int tid = threadIdx.x; asm volatile("" : "+v"(tid));
        const int lane = tid & 63, wv = tid >> 6;
        { RowMap rm{p.out, xc, 1, b}; normmod_phase(RB, rm, p.norm_mix_g + 1024, mod1, 0, 1024, hA, bid * 8 + wv, nb * 8, lane); }
        xcd_barrier(xb);
        { EpiRet e{q1, kz, v1, sg, p.ret_log_rate}; gemm_phase(hA, D, Wt + W1_IN, 1024, RB, 8192, 1024, e, smem); }
        xcd_barrier(xb);
        {
            bf16_t* Ks = (bf16_t*)smem;
            const int fr = lane & 15, fq = lane >> 4;
            for (int u = bid; u < 512; u += nb) {
                const int n = u & 63, h = (u >> 6) & 3, dir = u >> 8;
                const float lg = -__expf(p.ret_log_rate[dir * 4 + h]);
                __syncthreads();
                for (int i = tid; i < 256 * 16; i += NT) {
                    const int dk = i >> 4, t8 = (i & 15) * 8;
                    const uint4 v = *(const uint4*)(kz + ((size_t)dir * 1024 + h * 256 + dk) * RB + n * 128 + t8);
#pragma unroll
                    for (int k = 0; k < 8; ++k) Ks[(t8 + k) * 264 + dk] = u4e(v, k);
                }
                __syncthreads();
                f32x4 acc[8];
#pragma unroll
                for (int i = 0; i < 8; ++i) acc[i] = (f32x4){0.f, 0.f, 0.f, 0.f};
                const bf16_t* qp = q1 + ((size_t)dir * SEQ + n * 128 + wv * 16 + fr) * 1024 + h * 256 + fq * 8;
#pragma unroll
                for (int ks = 0; ks < 8; ++ks) {
                    const bf16x8 af = *(const bf16x8*)(qp + ks * 32);
#pragma unroll
                    for (int nt = 0; nt < 8; ++nt) { const bf16x8 bfv = *(const bf16x8*)(Ks + (nt * 16 + fr) * 264 + ks * 32 + fq * 8); acc[nt] = mfma16(af, bfv, acc[nt]); }
                }
                bf16_t* dst = inn + ((size_t)(dir * 4 + h) * 64 + n) * 16384;
#pragma unroll
                for (int j = 0; j < 4; ++j) {
                    const int a = wv * 16 + fq * 4 + j;
                    const float fac = dir == 0 ? __expf((float)(a - 127) * lg) : __expf(-(float)a * lg);
#pragma unroll
                    for (int nt = 0; nt < 8; ++nt) { const int ap = nt * 16 + fr; const bool ok = dir == 0 ? (a >= ap) : (ap >= a); dst[a * 128 + ap] = f2bf(ok ? acc[nt][j] * fac : 0.f); }
                }
            }
        }
        xcd_barrier(xb);
        {
            bf16_t* Wq = (bf16_t*)(smem + wv * 8192);
            bf16_t* Wi = (bf16_t*)(smem + 65536 + wv * 4096);
            bf16_t* Wg = (bf16_t*)(smem + 98304 + wv * 512);
            bf16_t* Vs = (bf16_t*)(smem + 102400);
            bf16_t* Rl = (bf16_t*)(smem + 110592);
            const int fr = lane & 15, fq = lane >> 4;
            for (int wk0 = bid; wk0 < 256; wk0 += nb) {
                const int wk = (wk0 & 7) * 32 + (wk0 >> 3);
                const int sl = wk & 31, h = (wk >> 5) & 3, dir = wk >> 7;
                const float lg = -__expf(p.ret_log_rate[dir * 4 + h]); const float gC = __expf(128.f * lg);
                const int vcol = h * 512 + sl * 16;
                f32x4 racc0 = (f32x4){0.f, 0.f, 0.f, 0.f}, racc1 = racc0;
                const bf16_t* qg_p = q1 + ((size_t)dir * SEQ + wv * 16 + (lane >> 5)) * 1024 + h * 256 + (lane & 31) * 8;
                const bf16_t* kg_p = kz + ((size_t)dir * 1024 + h * 256 + wv * 32 + (lane >> 4)) * RB + (lane & 15) * 8;
                const bf16_t* ig_p = inn + ((size_t)(dir * 4 + h) * 64) * 16384 + (wv * 16 + (lane >> 4)) * 128 + (lane & 15) * 8;
                const bf16_t* vg_p = v1 + (size_t)(vcol + ((tid >> 4) & 15)) * RB + (tid & 15) * 8;
                bf16_t* gg_p = sg + ((size_t)dir * SEQ + wv * 16 + ((lane >> 1) & 15)) * 2048 + vcol + (lane & 1) * 8;
                float* pg_p = ps + (((size_t)dir * SEQ + wv * 16 + fq * 4) * 4 + h) * 32 + sl;
                bf16_t* qs_d = Wq + (lane >> 5) * 256 + (((lane & 31) ^ (lane >> 5)) * 8);
                bf16_t* ks_d = Wq + (lane >> 4) * 128;
                bf16_t* is_d = Wi + (lane >> 4) * 128;
                bf16_t* vs_d = Vs + ((tid >> 4) & 15) * 128 + (((tid & 15) ^ ((tid >> 4) & 15)) * 8);
                bf16_t* gs_d = Wg + ((lane >> 1) & 15) * 16 + (lane & 1) * 8;
                (void)qs_d;
                float xi[4];
#pragma unroll
                for (int j = 0; j < 4; ++j) { const int a = wv * 16 + fq * 4 + j; xi[j] = dir == 0 ? __expf((float)(a + 1) * lg) : __expf((float)(128 - a) * lg); }
#define SC_ROW(st) ((st) < 2 ? SEQ + (dir == 0 ? (st) : 1 - (st)) * 128 : (dir == 0 ? (st) - 2 : 65 - (st)) * 128)
                uint4 qg0, qg1, qg2, qg3, qg4, qg5, qg6, qg7, kg0, kg1, kg2, kg3, kg4, kg5, kg6, kg7, ig0, ig1, ig2, ig3, vg, gg;
                qg0 = qg1 = qg2 = qg3 = qg4 = qg5 = qg6 = qg7 = make_uint4(0, 0, 0, 0); ig0 = ig1 = ig2 = ig3 = qg0; gg = qg0; vg = qg0;
#define SC_LDK(r0) { const bf16_t* kp_ = kg_p + (r0); kg0 = *(const uint4*)(kp_); kg1 = *(const uint4*)(kp_ + (size_t)4 * RB); kg2 = *(const uint4*)(kp_ + (size_t)8 * RB); kg3 = *(const uint4*)(kp_ + (size_t)12 * RB); \
    kg4 = *(const uint4*)(kp_ + (size_t)16 * RB); kg5 = *(const uint4*)(kp_ + (size_t)20 * RB); kg6 = *(const uint4*)(kp_ + (size_t)24 * RB); kg7 = *(const uint4*)(kp_ + (size_t)28 * RB); }
#define SC_LDQ(r0) { const bf16_t* qp_ = qg_p + (size_t)(r0) * 1024; qg0 = *(const uint4*)(qp_); qg1 = *(const uint4*)(qp_ + 2 * 1024); qg2 = *(const uint4*)(qp_ + 4 * 1024); qg3 = *(const uint4*)(qp_ + 6 * 1024); \
    qg4 = *(const uint4*)(qp_ + 8 * 1024); qg5 = *(const uint4*)(qp_ + 10 * 1024); qg6 = *(const uint4*)(qp_ + 12 * 1024); qg7 = *(const uint4*)(qp_ + 14 * 1024); \
    const bf16_t* ip_ = ig_p + (size_t)((r0) >> 7) * 16384; ig0 = *(const uint4*)(ip_); ig1 = *(const uint4*)(ip_ + 4 * 128); ig2 = *(const uint4*)(ip_ + 8 * 128); ig3 = *(const uint4*)(ip_ + 12 * 128); \
    if (lane < 32) gg = *(const uint4*)(gg_p + (size_t)(r0) * 2048); }
#define SC_STQ(i, v) { const int row_ = 2 * (i) + (lane >> 5); *(uint4*)(Wq + row_ * 256 + (((lane & 31) ^ row_) * 8)) = (v); }
#define SC_STK(i, v) { const int row_ = 4 * (i) + (lane >> 4); *(uint4*)(ks_d + 4 * (i) * 128 + (((lane & 15) ^ (row_ & 15)) * 8)) = (v); }
#define SC_STI(i, v) { const int row_ = 4 * (i) + (lane >> 4); *(uint4*)(is_d + 4 * (i) * 128 + (((lane & 15) ^ (row_ & 15)) * 8)) = (v); }
                SC_LDK(SC_ROW(0))
                if (tid < 256) vg = *(const uint4*)(vg_p + SC_ROW(0));
#pragma unroll 2
                for (int st = 0; st < 66; ++st) {
                    const bool lat = st >= 2; const int row0 = SC_ROW(st); const int nrow = SC_ROW(st + 1);
                    const bool hasn = st + 1 < 66; const bool nlat = st + 1 >= 2 && hasn;
                    bf16_t* vsb = Vs + (st & 1) * 2048;
                    if (lat) {
                        SC_STQ(0, qg0) SC_STQ(1, qg1) SC_STQ(2, qg2) SC_STQ(3, qg3) SC_STQ(4, qg4) SC_STQ(5, qg5) SC_STQ(6, qg6) SC_STQ(7, qg7)
                        SC_STI(0, ig0) SC_STI(1, ig1) SC_STI(2, ig2) SC_STI(3, ig3)
                        if (lane < 32) *(uint4*)(gs_d) = gg;
                        bf16_t* rw = Rl + (st & 1) * 16 * 264 + fr * 264 + wv * 32 + fq * 4;
                        uint2 t; t.x = pk2(racc0[0], racc0[1]); t.y = pk2(racc0[2], racc0[3]); *(uint2*)(rw) = t;
                        t.x = pk2(racc1[0], racc1[1]); t.y = pk2(racc1[2], racc1[3]); *(uint2*)(rw + 16) = t;
                    }
                    if (tid < 256) *(uint4*)(vs_d + (st & 1) * 2048) = vg;
                    if (nlat) SC_LDQ(nrow)
                    if (hasn && tid < 256) vg = *(const uint4*)(vg_p + nrow);
                    __syncthreads();
                    const bf16x8 vf0 = *(const bf16x8*)(vsb + fr * 128 + (((0 + fq) ^ fr) * 8)), vf1 = *(const bf16x8*)(vsb + fr * 128 + (((4 + fq) ^ fr) * 8));
                    const bf16x8 vf2 = *(const bf16x8*)(vsb + fr * 128 + (((8 + fq) ^ fr) * 8)), vf3 = *(const bf16x8*)(vsb + fr * 128 + (((12 + fq) ^ fr) * 8));
                    if (lat) {
                        f32x4 oq = (f32x4){0.f, 0.f, 0.f, 0.f}, oq2 = oq, oi = oq;
                        const bf16_t* qrow = Wq + fr * 256; const bf16_t* irow = Wi + fr * 128;
                        const bf16_t* rl = Rl + (st & 1) * 16 * 264 + fr * 264 + fq * 8;
#pragma unroll
                        for (int ks = 0; ks < 8; ks += 2) {
                            oq = mfma16(*(const bf16x8*)(qrow + (((ks * 4 + fq) ^ fr) * 8)), *(const bf16x8*)(rl + ks * 32), oq);
                            oq2 = mfma16(*(const bf16x8*)(qrow + ((((ks + 1) * 4 + fq) ^ fr) * 8)), *(const bf16x8*)(rl + (ks + 1) * 32), oq2);
                        }
                        oi = mfma16(*(const bf16x8*)(irow + (((0 + fq) ^ fr) * 8)), vf0, oi); oi = mfma16(*(const bf16x8*)(irow + (((4 + fq) ^ fr) * 8)), vf1, oi);
                        oi = mfma16(*(const bf16x8*)(irow + (((8 + fq) ^ fr) * 8)), vf2, oi); oi = mfma16(*(const bf16x8*)(irow + (((12 + fq) ^ fr) * 8)), vf3, oi);
                        float ov[4];
#pragma unroll
                        for (int j = 0; j < 4; ++j) ov[j] = oi[j] + xi[j] * (oq[j] + oq2[j]);
                        const float q0_ = row16_sum(ov[0] * ov[0]), q1_ = row16_sum(ov[1] * ov[1]), q2_ = row16_sum(ov[2] * ov[2]), q3_ = row16_sum(ov[3] * ov[3]);
                        if (fr == 0) { float* pp = pg_p + (size_t)row0 * 128; pp[0] = q0_; pp[128] = q1_; pp[256] = q2_; pp[384] = q3_; }
                        bf16_t* gp_ = Wg + (fq * 4) * 16 + fr;
#pragma unroll
                        for (int j = 0; j < 4; ++j) gp_[j * 16] = f2bf(bf2f(gp_[j * 16]) * ov[j]);
                        if (lane < 32) *(uint4*)(gg_p + (size_t)row0 * 2048) = *(const uint4*)(gs_d);
                    }
                    SC_STK(0, kg0) SC_STK(1, kg1) SC_STK(2, kg2) SC_STK(3, kg3) SC_STK(4, kg4) SC_STK(5, kg5) SC_STK(6, kg6) SC_STK(7, kg7)
                    if (hasn) SC_LDK(nrow)
                    racc0 = racc0 * gC; racc1 = racc1 * gC;
                    {
                        const bf16_t* k0 = Wq + fr * 128; const bf16_t* k1 = k0 + 16 * 128;
                        racc0 = mfma16(*(const bf16x8*)(k0 + (((0 + fq) ^ fr) * 8)), vf0, racc0); racc1 = mfma16(*(const bf16x8*)(k1 + (((0 + fq) ^ fr) * 8)), vf0, racc1);
                        racc0 = mfma16(*(const bf16x8*)(k0 + (((4 + fq) ^ fr) * 8)), vf1, racc0); racc1 = mfma16(*(const bf16x8*)(k1 + (((4 + fq) ^ fr) * 8)), vf1, racc1);
                        racc0 = mfma16(*(const bf16x8*)(k0 + (((8 + fq) ^ fr) * 8)), vf2, racc0); racc1 = mfma16(*(const bf16x8*)(k1 + (((8 + fq) ^ fr) * 8)), vf2, racc1);
                        racc0 = mfma16(*(const bf16x8*)(k0 + (((12 + fq) ^ fr) * 8)), vf3, racc0); racc1 = mfma16(*(const bf16x8*)(k1 + (((12 + fq) ^ fr) * 8)), vf3, racc1);
                    }
                }
                __syncthreads();
            }
        }
        xcd_barrier(xb);
        for (int u = bid; u < SEQ / 8; u += nb) {
            const int r = u * 8 + wv;
            float rv[4];
#pragma unroll
            for (int i = 0; i < 4; ++i) {
                const int dir = i >> 1, hh = (i & 1) * 2 + (lane >> 5), s = lane & 31;
                float v = ps[(((size_t)dir * SEQ + r) * 4 + hh) * 32 + s];
                v += __shfl_xor(v, 1); v += __shfl_xor(v, 2); v += __shfl_xor(v, 4); v += __shfl_xor(v, 8); v += __shfl_xor(v, 16);
                rv[i] = rsqrtf(v * (1.f / 512.f) + 1e-6f);
            }
            bf16_t* pf = sg + (size_t)r * 2048 + lane * 4; const bf16_t* pb = pf + (size_t)SEQ * 2048;
            uint2 la[8], lb[8];
#pragma unroll
            for (int it = 0; it < 8; ++it) { la[it] = *(const uint2*)(pf + it * 256); lb[it] = *(const uint2*)(pb + it * 256); }
#pragma unroll
            for (int it = 0; it < 8; ++it) {
                const int hh = it >> 1;
                const float rf = __shfl(rv[hh >> 1], (hh & 1) * 32), rbk = __shfl(rv[2 + (hh >> 1)], (hh & 1) * 32);
                const uint2 a = la[it], bq = lb[it];
                uint2 o; o.x = pk2(bf2f(u2e(a, 0)) * rf + bf2f(u2e(bq, 0)) * rbk, bf2f(u2e(a, 1)) * rf + bf2f(u2e(bq, 1)) * rbk); o.y = pk2(bf2f(u2e(a, 2)) * rf + bf2f(u2e(bq, 2)) * rbk, bf2f(u2e(a, 3)) * rf + bf2f(u2e(bq, 3)) * rbk);
                *(uint2*)(pf + it * 256) = o;
            }
        }
        xcd_barrier(xb);
        { EpiResLat e{p.out, mod1, 2048, b * SEQ}; gemm_phase(sg, 2048, Wt + W1_OUT, 2048, SEQ, 1024, 2048, e, smem); }
        xcd_barrier(xb);
    }
    int tid2 = threadIdx.x; asm volatile("" : "+v"(tid2));
    const int lane2 = tid2 & 63, wv2 = tid2 >> 6;
    { RowMap rm{p.out, xc, 2, 0}; normmod_phase(16384, rm, p.norm_mlp_g + 1024, mod1, 3072, 4096, hA, bid * 8 + wv2, nb * 8, lane2); }
    xcd_barrier(xb);
    { EpiRelu2 e{hid, 4096}; gemm_phase(hA, D, Wt + W1_1, 1024, 16384, 4096, 1024, e, smem); }
    xcd_barrier(xb);
    { EpiResLat e{p.out, mod1, 5120, 0}; gemm_phase(hid, 4096, Wt + W1_2, 4096, 16384, 1024, 4096, e, smem); }
    xcd_barrier(xb);
    for (int u = bid; u < 16384 / 8; u += nb) {
        const int r = u * 8 + wv2; float* row = p.out + (size_t)r * D;
        float4 v[4]; float ss = 0.f;
#pragma unroll
        for (int i = 0; i < 4; ++i) { v[i] = *(const float4*)(row + i * 256 + lane2 * 4); ss += v[i].x * v[i].x + v[i].y * v[i].y + v[i].z * v[i].z + v[i].w * v[i].w; }
#pragma unroll
        for (int o = 32; o >= 1; o >>= 1) ss += __shfl_xor(ss, o);
        const float rsd = rsqrtf(ss * (1.f / 1024.f) + 1e-6f);
#pragma unroll
        for (int i = 0; i < 4; ++i) { const float4 gg = *(const float4*)(p.final_g + i * 256 + lane2 * 4); *(float4*)(row + i * 256 + lane2 * 4) = make_float4(v[i].x * rsd * gg.x, v[i].y * rsd * gg.y, v[i].z * rsd * gg.z, v[i].w * rsd * gg.w); }
    }
}

extern "C" void kernel_launch(void* const* d_in, const int* in_sizes, int n_in, void* d_out, int out_size, void* d_ws, size_t ws_size, hipStream_t stream) {
    static int grid_blocks = 0;
    if (!grid_blocks) {
        int dev = 0, cus = 0, per_cu = 0;
        hipGetDevice(&dev);
        hipDeviceGetAttribute(&cus, hipDeviceAttributeMultiprocessorCount, dev);
        hipFuncSetAttribute((const void*)fwd_megakernel, hipFuncAttributeMaxDynamicSharedMemorySize, LDS_BYTES);
        hipOccupancyMaxActiveBlocksPerMultiprocessor(&per_cu, (const void*)fwd_megakernel, NT, LDS_BYTES);
        if (per_cu < 1) per_cu = 1;
        grid_blocks = (cus * per_cu) & ~7;
        if (ws_size < 256 * MiB) fprintf(stderr, "workspace too small: %zu\n", ws_size);
    }
    Params p{};
    const float** pp = (const float**)&p;
    for (int i = 0; i < 27; ++i) pp[i] = (const float*)d_in[i];
    p.out = (float*)d_out; p.ws = (unsigned char*)d_ws;
    (void)hipMemsetAsync((unsigned char*)d_ws + OFF_BAR, 0, XCD_BAR_WORDS * 4, stream);
    void* args[] = {&p};
    hipError_t e = hipLaunchCooperativeKernel((void*)fwd_megakernel, dim3(grid_blocks), dim3(NT), args, LDS_BYTES, stream);
    if (e != hipSuccess) fprintf(stderr, "cooperative launch failed: %s (grid %d)\n", hipGetErrorString(e), grid_blocks);
}
```
